# Optimizing an MI355X kernel written in HIP

```python
import math
import jax, jax.numpy as jnp
from jax import lax
import numpy as np

D_MODEL = 1024
BATCH = 2
SEQ = 8192
DEPTH = 4
DEC_BATCH = 128
DEC_SEQ = 1
PAST_LEN = 8192
PAGE_SIZE = 128

D_A = 512
HD_A = 64
H_A = D_A // HD_A
KV_A = 2
G_A = H_A // KV_A
WINDOW = 128
N_BUCKETS = 32
MAX_DIST = 128
D_B = 512
H_B = 8
DH_B = D_B // H_B
CHUNK_B = 128
D_C = 512
H_C = 4
DK_TOT = D_C // 2
DK_C = DK_TOT // H_C
DV_C = D_C // H_C
GLA_RANK = 16
GLA_TAU = 16.0
GLA_CHUNK = 64

D_MIX = D_A + D_B + D_C
EPS = 1e-6
NEG = -1e30
SPLITS = [D_A, KV_A * HD_A, KV_A * HD_A, D_A,
          D_B, D_B, D_B,
          DK_TOT, DK_TOT, D_C, D_C, GLA_RANK]
D_IN = sum(SPLITS)

kernel_name = "hymba_swa_gmlp_gla_step"


def rmsnorm(x, g):
    xf = x.astype(jnp.float32)
    y = xf * lax.rsqrt(jnp.mean(xf * xf, axis=-1, keepdims=True) + EPS)
    return (y * g.astype(jnp.float32)).astype(x.dtype)


def t5_bucket(dist):
    n = np.maximum(dist, 0)
    max_exact = N_BUCKETS // 2
    large = max_exact + (np.log(np.maximum(n, 1) / max_exact) / np.log(MAX_DIST / max_exact)
                         * (N_BUCKETS - max_exact)).astype(np.int32)
    large = np.minimum(large, N_BUCKETS - 1)
    return np.where(n < max_exact, n, large).astype(np.int32)


def rel_bias_lookup(rel_bias, dist):
    b = jnp.take(rel_bias.astype(jnp.float32), jnp.asarray(t5_bucket(dist)), axis=0)
    return jnp.moveaxis(b, -1, 0).reshape(KV_A, G_A, *dist.shape)


def attend_sinks(q, k, v, bias, mask, sink):
    logits = jnp.einsum('...qkgd,...skd->...kgqs', q, k).astype(jnp.float32) * (HD_A ** -0.5)
    logits = jnp.where(mask, logits + bias, NEG)
    s = sink.astype(jnp.float32).reshape(KV_A, G_A)[:, :, None]
    lse = jnp.logaddexp(jax.nn.logsumexp(logits, axis=-1), s)
    p = jnp.exp(logits - lse[..., None])
    return jnp.einsum('...kgqs,...skd->...qkgd', p.astype(v.dtype), v)


def swa_prompt(q, k, v, rel_bias, sink):
    B, S = q.shape[:2]
    nb = S // WINDOW
    qb = q.reshape(B, nb, WINDOW, KV_A, G_A, HD_A)
    pad = ((0, 0), (WINDOW, 0), (0, 0), (0, 0))
    kb = jnp.pad(k, pad).reshape(B, nb + 1, WINDOW, KV_A, HD_A)
    vb = jnp.pad(v, pad).reshape(B, nb + 1, WINDOW, KV_A, HD_A)
    keys = jnp.concatenate([kb[:, :-1], kb[:, 1:]], axis=2)
    vals = jnp.concatenate([vb[:, :-1], vb[:, 1:]], axis=2)
    i = np.arange(WINDOW)[:, None]
    j = np.arange(2 * WINDOW)[None, :]
    dist = i + WINDOW - j
    band = (dist >= 0) & (dist < WINDOW)
    kpos = np.arange(nb)[:, None, None] * WINDOW + j[None] - WINDOW
    mask = (band[None] & (kpos >= 0))[:, None, None]
    o = attend_sinks(qb, keys, vals, rel_bias_lookup(rel_bias, dist), mask, sink)
    return o.reshape(B, S, D_A)


def swa_sample(q, k, v, buf_k, buf_v, rel_bias, sink):
    Bd, T = q.shape[:2]
    Wb = buf_k.shape[1]
    keys = jnp.concatenate([buf_k.astype(k.dtype), k], axis=1)
    vals = jnp.concatenate([buf_v.astype(v.dtype), v], axis=1)
    dist = np.arange(T)[:, None] + Wb - np.arange(Wb + T)[None, :]
    mask = (dist >= 0) & (dist < WINDOW)
    o = attend_sinks(q.reshape(Bd, T, KV_A, G_A, HD_A), keys, vals,
                     rel_bias_lookup(rel_bias, dist), mask, sink)
    return o.reshape(Bd, T, D_A), keys[:, T:], vals[:, T:]


def chunk_mlp(u, v_raw, w_s, b_s, ln_g, ln_b):
    B, T = u.shape[:2]
    L = CHUNK_B if T % CHUNK_B == 0 else T
    nc = T // L
    vf = v_raw.astype(jnp.float32)
    mu = jnp.mean(vf, axis=-1, keepdims=True)
    var = jnp.mean(jnp.square(vf - mu), axis=-1, keepdims=True)
    vn = (vf - mu) * lax.rsqrt(var + EPS) * ln_g.astype(jnp.float32) + ln_b.astype(jnp.float32)
    wm = jnp.where(np.tril(np.ones((L, L), bool)), w_s[:, :L, :L].astype(jnp.float32), 0.0)
    mix = jnp.einsum('hij,bcjhd->bcihd', wm, vn.reshape(B, nc, L, H_B, DH_B))
    mix = mix + b_s[:, :L].astype(jnp.float32).T[:, :, None]
    out = u.astype(jnp.float32) * mix.reshape(B, T, D_B)
    return out.astype(u.dtype), vn.astype(u.dtype)


def gla(q, k, v, log_a, s0):
    B, T = q.shape[:2]
    L = math.gcd(T, GLA_CHUNK)
    nc = T // L
    f = lambda t, d: t.astype(jnp.float32).reshape(B, nc, L, H_C, d)
    q = f(q, DK_C) * (DK_C ** -0.5)
    k = f(k, DK_C)
    v = f(v, DV_C)
    b = jnp.cumsum(f(log_a, DK_C), axis=2)
    q_dec = q * jnp.exp(b)
    k_inv = k * jnp.exp(-b)
    causal = np.tril(np.ones((L, L), bool))
    att = jnp.where(causal, jnp.einsum('bnqhd,bnshd->bnhqs', q_dec, k_inv), 0.0)
    o = jnp.einsum('bnhqs,bnshv->bnqhv', att, v)
    b_last = b[:, :, -1]
    k_dec = k * jnp.exp(b_last[:, :, None] - b)
    dS = jnp.einsum('bnshd,bnshv->bnhdv', k_dec, v)

    def step(S, xs):
        a, d = xs
        return a[..., None] * S + d, S

    S_fin, S_prev = lax.scan(step, s0.astype(jnp.float32),
                             (jnp.moveaxis(jnp.exp(b_last), 1, 0), jnp.moveaxis(dS, 1, 0)))
    o = o + jnp.einsum('bnqhd,nbhdv->bnqhv', q_dec, S_prev)
    return o.reshape(B, T, H_C, DV_C), S_fin


def layer(x, g_norm, w_in_l, w_out_l, sink_l, sw_l, sb_l, ln_g_l, ln_b_l, wup_l, bup_l, gn_l,
          rel_bias, buf_k, buf_v, s0):
    B, T = x.shape[:2]
    h = rmsnorm(x, g_norm)
    proj = h @ w_in_l
    offs = [int(o) for o in np.cumsum(SPLITS)[:-1]]
    (qa, ka, va, ga, ub, vb, gb, qc, kc, vc, gc, lr) = jnp.split(proj, offs, axis=-1)
    ka = ka.reshape(B, T, KV_A, HD_A)
    va = va.reshape(B, T, KV_A, HD_A)
    if buf_k is None:
        ya = swa_prompt(qa, ka, va, rel_bias, sink_l)
        wb = min(WINDOW, T)
        new_k, new_v = ka[:, T - wb:], va[:, T - wb:]
    else:
        ya, new_k, new_v = swa_sample(qa, ka, va, buf_k, buf_v, rel_bias, sink_l)
    yb, v_rows = chunk_mlp(ub, vb, sw_l, sb_l, ln_g_l, ln_b_l)
    log_a = jax.nn.log_sigmoid((lr @ wup_l + bup_l).astype(jnp.float32)) / GLA_TAU
    oc, S_fin = gla(qc, kc, vc, log_a, s0)
    oc = oc * lax.rsqrt(jnp.mean(oc * oc, axis=-1, keepdims=True) + EPS)
    yc = (oc * gn_l.astype(jnp.float32).reshape(H_C, DV_C)).reshape(B, T, D_C).astype(x.dtype)
    y = jnp.concatenate([ya * jax.nn.silu(ga), yb * jax.nn.silu(gb), yc * jax.nn.silu(gc)], axis=-1)
    x = x + (y @ w_out_l).astype(x.dtype)
    return x, new_k, new_v, S_fin.astype(x.dtype), v_rows


def setup_inputs(seed: int = 0) -> dict:
    key = jax.random.key(seed)
    ks = jax.random.split(key, 20)
    nrm = lambda k, shape, s: jax.random.normal(k, shape, jnp.float32) * s
    wb = min(WINDOW, PAST_LEN)
    return {
        "x_prompt": nrm(ks[0], (BATCH, SEQ, D_MODEL), 1.0),
        "x_sample": nrm(ks[1], (DEC_BATCH, DEC_SEQ, D_MODEL), 1.0),
        "state_swa_k": nrm(ks[2], (DEPTH, DEC_BATCH, wb, KV_A, HD_A), 1.0),
        "state_swa_v": nrm(ks[3], (DEPTH, DEC_BATCH, wb, KV_A, HD_A), 1.0),
        "state_gla": nrm(ks[4], (DEPTH, DEC_BATCH, H_C, DK_C, DV_C), 0.5),
        "rel_bias": nrm(ks[5], (N_BUCKETS, H_A), 0.5),
        "norm_g": 1.0 + nrm(ks[6], (DEPTH, D_MODEL), 0.01),
        "w_in": nrm(ks[7], (DEPTH, D_MODEL, D_IN), D_MODEL ** -0.5),
        "sinks": nrm(ks[8], (DEPTH, H_A), 0.5),
        "spatial_w": nrm(ks[9], (DEPTH, H_B, CHUNK_B, CHUNK_B), 0.5 * CHUNK_B ** -0.5),
        "spatial_b": 1.0 + nrm(ks[10], (DEPTH, H_B, CHUNK_B), 0.01),
        "chunk_ln_g": 1.0 + nrm(ks[11], (DEPTH, D_B), 0.01),
        "chunk_ln_b": nrm(ks[12], (DEPTH, D_B), 0.01),
        "gla_w_up": nrm(ks[13], (DEPTH, GLA_RANK, DK_TOT), GLA_RANK ** -0.5),
        "gla_b_up": nrm(ks[14], (DEPTH, DK_TOT), 0.1),
        "gla_norm_g": 1.0 + nrm(ks[15], (DEPTH, D_C), 0.01),
        "w_out": nrm(ks[16], (DEPTH, D_MIX, D_MODEL), 0.5 * D_MIX ** -0.5),
        "final_norm_g": 1.0 + nrm(ks[17], (D_MODEL,), 0.01),
    }


def reference(x_prompt, x_sample, state_swa_k, state_swa_v, state_gla, rel_bias, norm_g, w_in, sinks,
              spatial_w, spatial_b, chunk_ln_g, chunk_ln_b, gla_w_up, gla_b_up, gla_norm_g, w_out,
              final_norm_g):
    xp, xs = x_prompt, x_sample
    s0_prompt = jnp.zeros((xp.shape[0], H_C, DK_C, DV_C), jnp.float32)
    kp_l, vp_l, sp_l, ks_l, vs_l, ss_l, cv_l = [], [], [], [], [], [], []
    for l in range(DEPTH):
        w = (norm_g[l], w_in[l], w_out[l], sinks[l], spatial_w[l], spatial_b[l], chunk_ln_g[l],
             chunk_ln_b[l], gla_w_up[l], gla_b_up[l], gla_norm_g[l], rel_bias)
        xp, kp, vp, sp, _ = layer(xp, *w, None, None, s0_prompt)
        xs, k_s, v_s, s_s, cv = layer(xs, *w, state_swa_k[l], state_swa_v[l], state_gla[l])
        kp_l.append(kp); vp_l.append(vp); sp_l.append(sp)
        ks_l.append(k_s); vs_l.append(v_s); ss_l.append(s_s); cv_l.append(cv)
    y_prompt = rmsnorm(xp, final_norm_g)
    y_sample = rmsnorm(xs, final_norm_g)
    return (y_prompt, y_sample, jnp.stack(kp_l), jnp.stack(vp_l), jnp.stack(sp_l),
            jnp.stack(ks_l), jnp.stack(vs_l), jnp.stack(ss_l), jnp.stack(cv_l))
```

```cpp
#include <hip/hip_runtime.h>
#include <cstdio>
#include <cstdint>
#ifndef MK_N_LAUNCHES
#define MK_N_LAUNCHES 1
#endif
constexpr int MP = 16384, MS = 128, MT = MP + MS, DM = 1024, NIN = 4608, LDP = 4352, DMIX = 1536, SEQ = 8192, DEPTH = 4;
constexpr int DIN_RAW = 4368;
constexpr float EPS = 1e-6f, LOG2E = 1.4426950408889634f, LN2 = 0.6931471805599453f;
constexpr int C_QA = 0, C_KA = 512, C_VA = 640, C_GA = 768, C_UB = 1280, C_VB = 1792, C_GB = 2304, C_QC = 2816, C_KC = 3072, C_VC = 3328, C_GC = 3840;
__device__ __forceinline__ float silu_f(float v) { return v * __builtin_amdgcn_rcpf(1.f + __builtin_amdgcn_exp2f(-v * LOG2E)); }
__device__ __forceinline__ float logsig_f(float z) { return fminf(z, 0.f) - LN2 * __builtin_amdgcn_logf(1.f + __builtin_amdgcn_exp2f(-fabsf(z) * LOG2E)); }
__device__ __forceinline__ int in_kind(int pn) { return (pn < 2) ? 2 : (pn == 2) ? 4 : (pn == 3 || pn == 4 || pn == 9 || pn == 10 || pn == 15 || pn == 16) ? 1 : (pn == 11) ? 3 : (pn == 17) ? 5 : 0; }
__device__ __forceinline__ float in_xform(float v, int kind) { return kind == 1 ? silu_f(v) : kind == 2 ? v * (0.125f * LOG2E) : kind == 3 ? v * 0.125f : v; }
constexpr size_t WSO_XB = 13u << 20, WSO_PROJ = 46u << 20, WSO_LA = 184u << 20, WSO_ROWSS = (282u << 20) + (1u << 19);
constexpr size_t OO_KP = 16908288, OO_VP = 17039360;
struct Args { const float* in[18]; float* out; unsigned char* ws; int ph_lo, ph_hi, li, pad; };
typedef const __attribute__((address_space(4))) Args* kargs_t;
__device__ __forceinline__ kargs_t KA() { kargs_t p = (kargs_t)__builtin_amdgcn_kernarg_segment_ptr(); asm volatile("" : "+s"(p)); return p; }
namespace pg8 {
#define PG8_LAS __attribute__((address_space(3)))
typedef unsigned short bf16_t;
typedef short bf16x8 __attribute__((ext_vector_type(8)));
typedef float f32x4 __attribute__((ext_vector_type(4)));
typedef unsigned u32x4 __attribute__((ext_vector_type(4)));
constexpr int BM = 256, BK = 64, HALF = 128, HTB = HALF * BK * 2  , STAGE_BYTES = 8 * HTB, NXCD = 8, WGM = 8;

__host__ __device__ __forceinline__ int lds_byte(int r, int c) { const int st = (r >> 4) * 2 + (c >> 5), rr = r & 15, cc = c & 31, ob = rr * 64 + cc * 2; return st * 1024 + (ob ^ (((ob >> 9) & 1) << 5)); }
__host__ __device__ __forceinline__ void stage_rc(int b, int& R, int& C) { const int st = b / 1024, sb = b % 1024, swz = sb ^ (((sb >> 9) & 1) << 5); R = (st >> 1) * 16 + swz / 64; C = (st & 1) * 32 + (swz % 64) / 2; }
__host__ __device__ __forceinline__ int perm32(int rho) { const int n = rho >> 4, i = rho & 15; return 8 * (i >> 2) + 4 * n + (i & 3); }

struct Unit { int pm, pn; };
struct Gemm { const bf16_t* A; const bf16_t* Bt; int M, N, K; };

struct StaticOrder {
    int nM, nN, nwg, G, c;
    __host__ __device__ void init(int M, int N, int G_, int c_) { nM = M / BM; nN = N / BM; nwg = nM * nN; G = G_; c = c_; }
    __host__ __device__ bool next(int i, Unit& u) const {
        const long L = (long)i * G + c; if (L >= nwg) return false;
        int wgid = (int)L; { const int q = nwg / NXCD, r = nwg % NXCD, xcd = wgid % NXCD, off = wgid / NXCD; wgid = (xcd < r ? xcd * (q + 1) : r * (q + 1) + (xcd - r) * q) + off; }
        const int nig = WGM * nN, gid = wgid / nig, fm = gid * WGM, gsz = (nM - fm) < WGM ? (nM - fm) : WGM;
        u.pm = fm + ((wgid % nig) % gsz); u.pn = (wgid % nig) / gsz; return true;
    }
    __device__ __forceinline__ void a_ready(const Unit&) const {}
    __device__ __forceinline__ void done(const Unit&) const {}
};

__device__ __forceinline__ unsigned cvt_pk_bf16(float lo, float hi) { unsigned r; asm volatile("v_cvt_pk_bf16_f32 %0, %1, %2" : "=v"(r) : "v"(lo), "v"(hi)); return r; }
typedef float f32x2 __attribute__((ext_vector_type(2)));
struct EpiIn {
    static constexpr bool PERM = true, AFTER_DRAIN = false;
    int l;
    __device__ __forceinline__ void operator()(const f32x4 (&acc)[2][2][4][2], const Unit& u, int wr, int wc, int fr, int fq) const {
        const kargs_t ka = KA(); unsigned char* const ws = ka->ws;
        bf16_t* const proj = (bf16_t*)(ws + WSO_PROJ); float* const la = (float*)(ws + WSO_LA); const float* const rowss = (const float*)(ws + WSO_ROWSS); const float* const bup = ka->in[14] + l * 256;
        float* const outk = ka->out + OO_KP + (size_t)l * 32768; float* const outv = ka->out + OO_VP + (size_t)l * 32768;
        const int kind = in_kind(u.pn);
        const int row0 = u.pm * BM + wr * 64 + fr, ct = wc * 32 + 8 * fq;
        if (kind == 5) {
            f32x4 bv[2][2];
#pragma unroll
            for (int bj = 0; bj < 2; ++bj)
#pragma unroll
                for (int n = 0; n < 2; ++n) bv[bj][n] = *(const f32x4*)(bup + ct + bj * HALF + 4 * n);
#pragma unroll
            for (int ai = 0; ai < 2; ++ai)
#pragma unroll
                for (int m = 0; m < 4; ++m) { const int r = row0 + ai * HALF + m * 16;
                    const float rs = 1.0f / sqrtf(((rowss[r] + rowss[MT + r]) + (rowss[2 * MT + r] + rowss[3 * MT + r])) * (1.0f / DM) + EPS);
                    float* rowp = la + (size_t)r * 256 + ct;
#pragma unroll
                    for (int bj = 0; bj < 2; ++bj)
#pragma unroll
                        for (int n = 0; n < 2; ++n) { const f32x4 z = acc[ai][bj][m][n] * rs + bv[bj][n]; f32x4 o;
                            o[0] = logsig_f(z[0]) * 0.0625f; o[1] = logsig_f(z[1]) * 0.0625f; o[2] = logsig_f(z[2]) * 0.0625f; o[3] = logsig_f(z[3]) * 0.0625f;
                            *(f32x4*)(rowp + bj * HALF + 4 * n) = o; } }
            return;
        }
        const bool tail = (kind == 4) && ((u.pm & 31) == 31);
#pragma unroll
        for (int ai = 0; ai < 2; ++ai)
#pragma unroll
            for (int m = 0; m < 4; ++m) { const int r = row0 + ai * HALF + m * 16;
                const float rs = 1.0f / sqrtf(((rowss[r] + rowss[MT + r]) + (rowss[2 * MT + r] + rowss[3 * MT + r])) * (1.0f / DM) + EPS);
                bf16_t* rowp = proj + (size_t)r * LDP + u.pn * BM + ct;
#pragma unroll
                for (int bj = 0; bj < 2; ++bj) { f32x4 v0 = acc[ai][bj][m][0] * rs, v1 = acc[ai][bj][m][1] * rs;
                    if (tail && ai == 1) { float* dst = (bj ? outv : outk) + (size_t)((u.pm >> 5) * 128 + wr * 64 + m * 16 + fr) * 128 + ct; *(f32x4*)dst = v0; *(f32x4*)(dst + 4) = v1; }
                    if (kind != 0 && kind != 4) {
#pragma unroll
                        for (int i = 0; i < 4; ++i) { v0[i] = in_xform(v0[i], kind); v1[i] = in_xform(v1[i], kind); } }
                    u32x4 w; w.x = cvt_pk_bf16(v0[0], v0[1]); w.y = cvt_pk_bf16(v0[2], v0[3]); w.z = cvt_pk_bf16(v1[0], v1[1]); w.w = cvt_pk_bf16(v1[2], v1[3]);
                    *(u32x4*)(rowp + bj * HALF) = w; } }
    }
};
struct EpiOut {
    static constexpr bool PERM = false, AFTER_DRAIN = true;
    int l;
    __device__ __forceinline__ void fused(f32x4 (&acc)[2][2][4][2], const Unit& u, int wr, int wc, int fr, int fq, PG8_LAS unsigned char* lds, int wid, int lane) const {
        const kargs_t ka = KA(); unsigned char* const ws = ka->ws;
        float* const xnew = ka->out; const float* const xold = l == 0 ? ka->in[0] : (const float*)xnew; bf16_t* const xb = (bf16_t*)(ws + WSO_XB); float* const rowss = (float*)(ws + WSO_ROWSS);
        typedef unsigned u32x2v __attribute__((ext_vector_type(2)));
        PG8_LAS float* P = (PG8_LAS float*)lds;
        const int col0 = u.pn * BM + wc * 32 + 4 * fq;
#pragma unroll
        for (int ai = 0; ai < 2; ++ai)
#pragma unroll
            for (int m = 0; m < 4; ++m) { const int rl = ai * HALF + wr * 64 + m * 16 + fr; const size_t off = (size_t)(u.pm * BM + rl) * DM + col0; float ss = 0.f;
#pragma unroll
                for (int bj = 0; bj < 2; ++bj)
#pragma unroll
                    for (int n = 0; n < 2; ++n) { const f32x4 xo = *(const f32x4*)(xold + off + bj * HALF + n * 16); const f32x4 xn = xo + acc[ai][bj][m][n];
                        *(f32x4*)(xnew + off + bj * HALF + n * 16) = xn; u32x2v w; w.x = cvt_pk_bf16(xn[0], xn[1]); w.y = cvt_pk_bf16(xn[2], xn[3]);
                        *(u32x2v*)(xb + off + bj * HALF + n * 16) = w; ss += (xn[0] * xn[0] + xn[1] * xn[1]) + (xn[2] * xn[2] + xn[3] * xn[3]); }
                ss += __shfl_xor(ss, 16); ss += __shfl_xor(ss, 32);
                if (fq == 0) P[rl * 4 + wc] = ss;
                if (m & 1) asm volatile("" ::: "memory"); }
        asm volatile("s_waitcnt lgkmcnt(0)" ::: "memory"); __builtin_amdgcn_s_barrier(); asm volatile("" ::: "memory");
        const int t = wid * 64 + lane;
        if (t < 256) rowss[(size_t)u.pn * MT + u.pm * BM + t] = (P[t * 4 + 0] + P[t * 4 + 1]) + (P[t * 4 + 2] + P[t * 4 + 3]);
    }
};

template <class Epi, class Sched, bool ALIGN_EPI = false, bool SP2 = false>
__device__ __forceinline__ void gemm_phase(PG8_LAS unsigned char* lds, const Gemm g, const Sched& S, const Epi& E) {
    int tid_l = threadIdx.x; asm volatile("" : "+v"(tid_l));
    const int tid = tid_l, wid = __builtin_amdgcn_readfirstlane(tid >> 6), lane = tid & 63, wr = wid >> 2, wc = wid & 3, fr = lane & 15, fq = lane >> 4;
    const int K = g.K, nt = K / BK;
    unsigned voffA[2], voffB[2];
#pragma unroll
    for (int i = 0; i < 2; ++i) { int R, C; stage_rc(tid * 16 + i * 8192, R, C); const int Rb = Epi::PERM ? ((R & ~31) + perm32(R & 31)) : R;
        voffA[i] = (unsigned)(R * K + C) * 2u; voffB[i] = (unsigned)(Rb * K + C) * 2u; }
    const size_t kstep = (size_t)(BK * 2);
    const size_t hstep = (size_t)HALF * K * 2;
    const size_t tstep = 2 * hstep;
    const unsigned ldsw = (unsigned)wid * 1024u;
    const int aoff = lds_byte(wr * 64 + fr, fq * 8), boff = lds_byte(wc * 32 + fr, fq * 8);
#define PG8_SA(b, h) (((b) * 2 + (h)) * HTB)
#define PG8_SB(b, h) ((4 + (b) * 2 + (h)) * HTB)
#define PG8_STAGE(bufoff, gbase, voff) do { _Pragma("unroll") for (int _i = 0; _i < 2; ++_i) \
        __builtin_amdgcn_global_load_lds((const unsigned*)((const char*)(gbase) + (voff)[_i]), (PG8_LAS unsigned*)(lds + (bufoff) + ldsw + _i * 8192), 16, 0, 0); } while (0)
#define PG8_LDA(dst, b, h) do { _Pragma("unroll") for (int m = 0; m < 4; ++m) _Pragma("unroll") for (int k = 0; k < 2; ++k) dst[m][k] = *(const PG8_LAS bf16x8*)(lds + PG8_SA(b, h) + aoff + m * 2048 + k * 1024); } while (0)
#define PG8_LDB(dst, b, h) do { _Pragma("unroll") for (int n = 0; n < 2; ++n) _Pragma("unroll") for (int k = 0; k < 2; ++k) dst[n][k] = *(const PG8_LAS bf16x8*)(lds + PG8_SB(b, h) + boff + n * 2048 + k * 1024); } while (0)
#define PG8_MMA(ai, bj, At, Bt) do { __builtin_amdgcn_s_setprio(1); _Pragma("unroll") for (int m = 0; m < 4; ++m) _Pragma("unroll") for (int n = 0; n < 2; ++n) _Pragma("unroll") for (int k = 0; k < 2; ++k) \
        acc[ai][bj][m][n] = __builtin_amdgcn_mfma_f32_16x16x32_bf16(Bt[n][k], At[m][k], acc[ai][bj][m][n], 0, 0, 0); __builtin_amdgcn_s_setprio(0); } while (0)
#define PG8_WAIT_V(n) asm volatile("s_waitcnt vmcnt(" #n ")" ::: "memory")
#define PG8_WAIT_L(n) asm volatile("s_waitcnt lgkmcnt(" #n ")" ::: "memory")
#define PG8_BAR __builtin_amdgcn_s_barrier()
#define PG8_SCHED __builtin_amdgcn_sched_barrier(0)
    Unit cur, nxt; int ui = 0;
    if (!S.next(0, cur)) return;
    f32x4 acc[2][2][4][2];
#pragma unroll
    for (int a = 0; a < 2; ++a)
#pragma unroll
        for (int b = 0; b < 2; ++b)
#pragma unroll
            for (int m = 0; m < 4; ++m)
#pragma unroll
                for (int n = 0; n < 2; ++n) acc[a][b][m][n] = (f32x4){0.f, 0.f, 0.f, 0.f};
    bf16x8 At[4][2], B0[2][2], B1[2][2];
    const char* cA = (const char*)g.A + (size_t)cur.pm * tstep; const char* cB = (const char*)g.Bt + (size_t)cur.pn * tstep;
    S.a_ready(cur);
    if constexpr (SP2) {
        PG8_STAGE(PG8_SB(0, 0), cB, voffB); PG8_STAGE(PG8_SB(0, 1), cB + hstep, voffB); PG8_STAGE(PG8_SA(0, 0), cA, voffA); PG8_STAGE(PG8_SA(0, 1), cA + hstep, voffA);
        if (wr == 1) PG8_BAR;
        PG8_WAIT_V(2); PG8_BAR;
        PG8_STAGE(PG8_SB(1, 0), cB + kstep, voffB); PG8_STAGE(PG8_SA(1, 0), cA + kstep, voffA); PG8_STAGE(PG8_SB(1, 1), cB + hstep + kstep, voffB);
        PG8_WAIT_V(6); PG8_BAR;
    } else {
        PG8_STAGE(PG8_SB(0, 0), cB, voffB); PG8_STAGE(PG8_SA(0, 0), cA, voffA); PG8_STAGE(PG8_SB(0, 1), cB + hstep, voffB); PG8_STAGE(PG8_SA(0, 1), cA + hstep, voffA);
        if (wr == 1) PG8_BAR;
        PG8_WAIT_V(4); PG8_BAR;
        PG8_STAGE(PG8_SB(1, 0), cB + kstep, voffB); PG8_STAGE(PG8_SA(1, 0), cA + kstep, voffA); PG8_STAGE(PG8_SB(1, 1), cB + hstep + kstep, voffB);
        PG8_WAIT_V(6); PG8_BAR;
    }
    for (;;) {
        const bool has_next = S.next(ui + 1, nxt);
        const char* nA = has_next ? (const char*)g.A + (size_t)nxt.pm * tstep : cA; const char* nB = has_next ? (const char*)g.Bt + (size_t)nxt.pn * tstep : cB;
        for (int t = 0; t < nt; t += 2) {
            const bool last = (t == nt - 2);
            const char* a1 = cA + (size_t)(t + 1) * kstep;
            const char* a2 = last ? nA : cA + (size_t)(t + 2) * kstep; const char* b2 = last ? nB : cB + (size_t)(t + 2) * kstep;
            const char* a3 = a2 + kstep; const char* b3 = b2 + kstep;
            if (last && has_next) S.a_ready(nxt);
            if constexpr (SP2) {
            PG8_LDB(B0, 0, 0); PG8_LDB(B1, 0, 1); PG8_SCHED; PG8_LDA(At, 0, 0); PG8_STAGE(PG8_SA(1, 1), a1 + hstep, voffA);
            PG8_WAIT_V(8); PG8_WAIT_L(0); PG8_BAR; PG8_MMA(0, 0, At, B0); PG8_MMA(0, 1, At, B1); PG8_BAR; PG8_SCHED;
            PG8_LDA(At, 0, 1); PG8_STAGE(PG8_SB(0, 0), b2, voffB); PG8_STAGE(PG8_SB(0, 1), b2 + hstep, voffB); PG8_STAGE(PG8_SA(0, 0), a2, voffA);
            PG8_WAIT_V(8); PG8_WAIT_L(0); PG8_BAR; PG8_MMA(1, 0, At, B0); PG8_MMA(1, 1, At, B1); PG8_BAR; PG8_SCHED;
            PG8_LDB(B0, 1, 0); PG8_LDB(B1, 1, 1); PG8_SCHED; PG8_LDA(At, 1, 0); PG8_STAGE(PG8_SA(0, 1), a2 + hstep, voffA);
            PG8_WAIT_V(8); PG8_WAIT_L(0); PG8_BAR; PG8_MMA(0, 0, At, B0); PG8_MMA(0, 1, At, B1); PG8_BAR; PG8_SCHED;
            PG8_LDA(At, 1, 1); PG8_STAGE(PG8_SB(1, 0), b3, voffB); PG8_STAGE(PG8_SB(1, 1), b3 + hstep, voffB); PG8_STAGE(PG8_SA(1, 0), a3, voffA);
            PG8_WAIT_V(8); PG8_WAIT_L(0); PG8_BAR; PG8_MMA(1, 0, At, B0); PG8_MMA(1, 1, At, B1); PG8_BAR; PG8_SCHED;
            } else {
            PG8_LDB(B0, 0, 0); PG8_SCHED; PG8_LDA(At, 0, 0); PG8_STAGE(PG8_SA(1, 1), a1 + hstep, voffA);
            PG8_WAIT_L(8); PG8_BAR; PG8_WAIT_L(0); PG8_MMA(0, 0, At, B0); PG8_BAR; PG8_SCHED;
            PG8_LDB(B1, 0, 1); PG8_STAGE(PG8_SB(0, 0), b2, voffB);
            PG8_BAR; PG8_WAIT_L(0); PG8_MMA(0, 1, At, B1); PG8_BAR;
            PG8_LDA(At, 0, 1); PG8_STAGE(PG8_SA(0, 0), a2, voffA);
            PG8_BAR; PG8_WAIT_L(0); PG8_MMA(1, 0, At, B0); PG8_BAR; PG8_SCHED;
            PG8_STAGE(PG8_SB(0, 1), b2 + hstep, voffB);
            PG8_WAIT_V(6); PG8_BAR; PG8_MMA(1, 1, At, B1); PG8_BAR;
            PG8_LDB(B0, 1, 0); PG8_SCHED; PG8_LDA(At, 1, 0); PG8_STAGE(PG8_SA(0, 1), a2 + hstep, voffA);
            PG8_WAIT_L(8); PG8_BAR; PG8_WAIT_L(0); PG8_MMA(0, 0, At, B0); PG8_BAR; PG8_SCHED;
            PG8_LDB(B1, 1, 1); PG8_STAGE(PG8_SB(1, 0), b3, voffB);
            PG8_BAR; PG8_WAIT_L(0); PG8_MMA(0, 1, At, B1); PG8_BAR;
            PG8_LDA(At, 1, 1); PG8_STAGE(PG8_SA(1, 0), a3, voffA);
            PG8_BAR; PG8_WAIT_L(0); PG8_MMA(1, 0, At, B0); PG8_BAR; PG8_SCHED;
            PG8_STAGE(PG8_SB(1, 1), b3 + hstep, voffB);
            PG8_WAIT_V(6); PG8_BAR; PG8_MMA(1, 1, At, B1); PG8_BAR;
            }
        }
        if constexpr (ALIGN_EPI) { if (wr == 0) PG8_BAR; }
        if constexpr (!Epi::AFTER_DRAIN) { E(acc, cur, wr, wc, fr, fq); S.done(cur); }
        if (!has_next) break;
#pragma unroll
        for (int a = 0; a < 2; ++a)
#pragma unroll
            for (int b = 0; b < 2; ++b)
#pragma unroll
                for (int m = 0; m < 4; ++m)
#pragma unroll
                    for (int n = 0; n < 2; ++n) acc[a][b][m][n] = (f32x4){0.f, 0.f, 0.f, 0.f};
        cur = nxt; cA = nA; cB = nB; ++ui;
        if constexpr (ALIGN_EPI) { if (wr == 1) PG8_BAR; }
    }
    PG8_WAIT_V(0);
    if constexpr (!ALIGN_EPI) { if (wr == 0) PG8_BAR; }
    PG8_BAR;
    if constexpr (Epi::AFTER_DRAIN) { E.fused(acc, cur, wr, wc, fr, fq, lds, wid, lane); S.done(cur); }
#undef PG8_SA
#undef PG8_SB
#undef PG8_STAGE
#undef PG8_LDA
#undef PG8_LDB
#undef PG8_MMA
#undef PG8_WAIT_V
#undef PG8_WAIT_L
#undef PG8_BAR
#undef PG8_SCHED
}
}
#define GAS __attribute__((address_space(1)))
#define LAS __attribute__((address_space(3)))
typedef unsigned short bf16;
typedef unsigned v4u __attribute__((ext_vector_type(4)));
typedef float f32x4 __attribute__((ext_vector_type(4)));
typedef short bf16x8 __attribute__((ext_vector_type(8)));
typedef GAS unsigned gu32;
typedef GAS unsigned long long gu64;
#define RLX_AGENT __ATOMIC_RELAXED, __HIP_MEMORY_SCOPE_AGENT
#define LDS_WAIT() asm volatile("s_waitcnt lgkmcnt(0)" ::: "memory")
#define VM_WAIT() asm volatile("s_waitcnt vmcnt(0)" ::: "memory")
__device__ __forceinline__ unsigned long long rt() { return __builtin_amdgcn_s_memrealtime(); }
__device__ __forceinline__ unsigned f2bf(float f) { unsigned u = __builtin_bit_cast(unsigned, f); return (u + 0x7fffu + ((u >> 16) & 1u)) >> 16; }
__device__ __forceinline__ unsigned pk2(float lo, float hi) { return f2bf(lo) | (f2bf(hi) << 16); }

#define XB_TMO      128
#define XB_XCNT(j)  (256  + 64 * (j))
#define XB_XSUB(j)  (1280 + 64 * (j))
#define XB_XGEN(j)  (2304 + 64 * (j))
#define XB_TOP      3328
#define XB_TOPGEN   3392
#define XCD_BAR_WORDS 3456
#define XB_SPIN_CAP (1u << 18)

__device__ __forceinline__ unsigned xb_ld(unsigned* p)              { return __hip_atomic_load(p, __ATOMIC_RELAXED, __HIP_MEMORY_SCOPE_AGENT); }
__device__ __forceinline__ unsigned xb_add(unsigned* p, unsigned v) { return __hip_atomic_fetch_add(p, v, __ATOMIC_RELAXED, __HIP_MEMORY_SCOPE_AGENT); }
__device__ __forceinline__ unsigned xb_xcc_id() { return (unsigned)__builtin_amdgcn_s_getreg((3 << 11) | 20) & 0xFu; }
#define XB_SPIN(cond, bar) do { unsigned _sp = 0; while (cond) { __builtin_amdgcn_s_sleep(1); \
    if ((++_sp & 255u) == 0u) { if (xb_ld(&(bar)[XB_TMO])) break; if (_sp > XB_SPIN_CAP) { atomicAdd(&(bar)[XB_TMO], 1u); break; } } } } while (0)

struct XcdBarrier {
    unsigned* bar; unsigned x;
    volatile LAS unsigned* st;
};

__device__ __forceinline__ XcdBarrier xcd_barrier_post(unsigned* bar, volatile LAS unsigned* st) {
    XcdBarrier b; b.bar = bar; b.x = xb_xcc_id(); b.st = st;
    if (threadIdx.x == 0) (void)xb_add(&bar[XB_XCNT(b.x)], 1u);
    return b;
}
__device__ __forceinline__ void xcd_barrier_complete(unsigned* bar, unsigned x, unsigned& nloc, unsigned& nx) {
    const unsigned G = gridDim.x * gridDim.y * gridDim.z;
    unsigned sum, cnt, mine, sp = 0u;
    for (;;) {
        sum = 0u; cnt = 0u; mine = 0u;
#pragma unroll
        for (unsigned j = 0; j < 16; ++j) { const unsigned c = xb_ld(&bar[XB_XCNT(j)]); sum += c; cnt += (c > 0u) ? 1u : 0u; mine = (j == x) ? c : mine; }
        if (sum == G) break;
        __builtin_amdgcn_s_sleep(1);
        if ((++sp & 255u) == 0u) { if (xb_ld(&bar[XB_TMO])) break; if (sp > XB_SPIN_CAP) { atomicAdd(&bar[XB_TMO], 1u); break; } }
    }
    nloc = mine > 0u ? mine : 1u; nx = cnt > 0u ? cnt : 1u;
}

__device__ __forceinline__ void xcd_barrier(const XcdBarrier& b) {
    asm volatile("s_waitcnt vmcnt(0)" ::: "memory");
    __syncthreads();
    if (threadIdx.x == 0) {
        unsigned* bar = b.bar;
        __builtin_amdgcn_s_waitcnt(0);
        unsigned nloc = b.st[0], nx = b.st[1];
        if (nloc == 0u) { xcd_barrier_complete(bar, b.x, nloc, nx); b.st[0] = nloc; b.st[1] = nx; }
        const unsigned old = xb_add(&bar[XB_XSUB(b.x)], 1u);
        const unsigned gen = old / nloc;
        if (old + 1u == (gen + 1u) * nloc) {
            __builtin_amdgcn_fence(__ATOMIC_RELEASE, "agent");
            asm volatile("s_waitcnt vmcnt(0)" ::: "memory");
            const unsigned og = xb_add(&bar[XB_TOP], 1u);
            const unsigned tg = og / nx;
            if (og + 1u == (tg + 1u) * nx) xb_add(&bar[XB_TOPGEN], 1u);
            else XB_SPIN(xb_ld(&bar[XB_TOPGEN]) == tg, bar);
            __builtin_amdgcn_fence(__ATOMIC_ACQUIRE, "agent");
            xb_add(&bar[XB_XGEN(b.x)], 1u);
            asm volatile("s_waitcnt vmcnt(0)" ::: "memory");
        } else {
            XB_SPIN(xb_ld(&bar[XB_XGEN(b.x)]) == gen, bar);
            __builtin_amdgcn_fence(__ATOMIC_ACQUIRE, "agent");
            asm volatile("s_waitcnt vmcnt(0)" ::: "memory");
        }
    }
    __syncthreads();
}
#define DI __device__ __forceinline__
typedef float f32x16 __attribute__((ext_vector_type(16)));
typedef short s16x4 __attribute__((ext_vector_type(4)));
typedef short v4i16_t __attribute__((ext_vector_type(4)));
typedef unsigned u32x2 __attribute__((ext_vector_type(2)));
typedef float f32x2_t __attribute__((ext_vector_type(2)));
typedef __bf16 bf16x2_t __attribute__((ext_vector_type(2)));
typedef LAS unsigned char* ldsp;
typedef const LAS unsigned char* cldsp;
DI unsigned cvtpk(float lo, float hi) { f32x2_t v = {lo, hi}; bf16x2_t b = __builtin_convertvector(v, bf16x2_t); return __builtin_bit_cast(unsigned, b); }
DI unsigned short f2b(float x) { return (unsigned short)(cvtpk(x, 0.f) & 0xffffu); }
DI float b2f(unsigned short h) { return __uint_as_float((unsigned)h << 16); }
DI float blo(unsigned w) { return __uint_as_float(w << 16); }
DI float bhi(unsigned w) { return __uint_as_float(w & 0xffff0000u); }
DI int crow(int reg, int h) { return (reg & 3) + 8 * (reg >> 2) + 4 * h; }
#define MFMA32(a, b, c) __builtin_amdgcn_mfma_f32_32x32x16_bf16((a), (b), (c), 0, 0, 0)
#define MFMA16(a, b, c) __builtin_amdgcn_mfma_f32_16x16x32_bf16((a), (b), (c), 0, 0, 0)
DI s16x4 tr4(cldsp p) { return __builtin_bit_cast(s16x4, __builtin_amdgcn_ds_read_tr16_b64_v4i16((LAS v4i16_t*)p)); }
DI bf16x8 trfrag(cldsp base, int stride, int k0a, int k0b, int n0, int lane) {
    const int q = (lane & 15) >> 2, p = lane & 3, blk = (lane >> 4) & 1;
    const int off = 2 * (n0 + 16 * blk) + 8 * p;
    const s16x4 lo = tr4(base + (k0a + q) * stride + off), hi = tr4(base + (k0b + q) * stride + off);
    return (bf16x8){lo[0], lo[1], lo[2], lo[3], hi[0], hi[1], hi[2], hi[3]};
}
DI bf16x8 pack8(const f32x16& x, int s) {
    v4u p; p.x = cvtpk(x[8 * s], x[8 * s + 1]); p.y = cvtpk(x[8 * s + 2], x[8 * s + 3]); p.z = cvtpk(x[8 * s + 4], x[8 * s + 5]); p.w = cvtpk(x[8 * s + 6], x[8 * s + 7]);
    return __builtin_bit_cast(bf16x8, p);
}
DI bf16x8 lds16(cldsp p) { return *(const LAS bf16x8*)p; }
#define WG_SYNC() __syncthreads()

__constant__ unsigned char T5_BUCKET[128] = {0, 1, 2, 3, 4, 5, 6, 7, 8, 9, 10, 11, 12, 13, 14, 15, 16, 16, 16, 17, 17, 18, 18, 18, 19, 19, 19, 20, 20, 20, 20, 21, 21, 21, 21, 22, 22, 22, 22, 22, 23, 23, 23, 23, 23, 23, 24, 24, 24, 24, 24, 24, 25, 25, 25, 25, 25, 25, 25, 26, 26, 26, 26, 26, 26, 26, 26, 27, 27, 27, 27, 27, 27, 27, 27, 27, 27, 28, 28, 28, 28, 28, 28, 28, 28, 28, 28, 29, 29, 29, 29, 29, 29, 29, 29, 29, 29, 29, 29, 30, 30, 30, 30, 30, 30, 30, 30, 30, 30, 30, 30, 30, 30, 31, 31, 31, 31, 31, 31, 31, 31, 31, 31, 31, 31, 31, 31, 31};

DI void conv_tile(const float* W, int ldw, int K, bf16* WT, int k0, int n0, int nrow0, const float* gk, LAS float* scr, int lane) {
#pragma unroll 8
    for (int i = 0; i < 32; ++i) { const int kk = 2 * i + (lane >> 5); float v = W[(size_t)(k0 + kk) * ldw + n0 + (lane & 31)]; if (gk) v *= gk[k0 + kk]; scr[kk * 33 + (lane & 31)] = v; }
    LDS_WAIT(); asm volatile("" ::: "memory");
    const int c = lane & 7;
#pragma unroll
    for (int j = 0; j < 4; ++j) { const int n = (lane >> 3) + 8 * j; const LAS float* s = scr + (8 * c) * 33 + n;
        v4u o; o.x = cvtpk(s[0 * 33], s[1 * 33]); o.y = cvtpk(s[2 * 33], s[3 * 33]); o.z = cvtpk(s[4 * 33], s[5 * 33]); o.w = cvtpk(s[6 * 33], s[7 * 33]);
        *(v4u*)(WT + (size_t)(nrow0 + n) * K + k0 + 8 * c) = o; }
    LDS_WAIT(); asm volatile("" ::: "memory");
}
DI void conv_tile_eff(const float* Wl, const float* wup, const float* gk, bf16* WT, int k0, int j0, LAS float* scr, int lane) {
    const int j = j0 + (lane & 31);
    float wu[16];
#pragma unroll
    for (int r = 0; r < 16; ++r) wu[r] = wup[r * 256 + j];
#pragma unroll 4
    for (int i = 0; i < 32; ++i) { const int kk = 2 * i + (lane >> 5); const float* wr = Wl + (size_t)(k0 + kk) * DIN_RAW + 4352; float s = 0.f;
#pragma unroll
        for (int r = 0; r < 16; ++r) s += wr[r] * wu[r];
        scr[kk * 33 + (lane & 31)] = s * gk[k0 + kk]; }
    LDS_WAIT(); asm volatile("" ::: "memory");
    const int c = lane & 7;
#pragma unroll
    for (int jj = 0; jj < 4; ++jj) { const int n = (lane >> 3) + 8 * jj; const LAS float* s = scr + (8 * c) * 33 + n;
        v4u o; o.x = cvtpk(s[0 * 33], s[1 * 33]); o.y = cvtpk(s[2 * 33], s[3 * 33]); o.z = cvtpk(s[4 * 33], s[5 * 33]); o.w = cvtpk(s[6 * 33], s[7 * 33]);
        *(v4u*)(WT + (size_t)(4352 + j0 + n) * DM + k0 + 8 * c) = o; }
    LDS_WAIT(); asm volatile("" ::: "memory");
}
constexpr int CONV_IN_WT = 16 * 136 + 16 * 8, CONV_IN_ITEMS = CONV_IN_WT / 8;
constexpr int CONV_OUT_WT = 24 * 32, CONV_OUT_ITEMS = CONV_OUT_WT / 8;
DI void conv_in_item(int it, const float* Wl, const float* wup, const float* gk, bf16* WT, ldsp lds, int wave, int lane) {
    LAS float* scr = (LAS float*)(lds + wave * 16384);
    const int wt = it * 8 + wave;
    if (wt < 16 * 136) conv_tile(Wl, DIN_RAW, DM, WT, 64 * (wt / 136), 32 * (wt % 136), 32 * (wt % 136), gk, scr, lane);
    else { const int e = wt - 16 * 136; conv_tile_eff(Wl, wup, gk, WT, 64 * (e >> 3), 32 * (e & 7), scr, lane); }
}
DI void conv_out_item(int it, const float* Wl, bf16* WT, ldsp lds, int wave, int lane) {
    LAS float* scr = (LAS float*)(lds + wave * 16384);
    const int wt = it * 8 + wave;
    conv_tile(Wl, DM, DMIX, WT, 64 * (wt >> 5), 32 * (wt & 31), 32 * (wt & 31), nullptr, scr, lane);
}
DI void row_to_bf16(const float* xrow, bf16* orow, float* ss0, float* ss1, float* ss2, float* ss3, int lane) {
    const f32x4* xr = (const f32x4*)xrow + lane; f32x4 v[4]; float s = 0.f;
#pragma unroll
    for (int j = 0; j < 4; ++j) { v[j] = xr[64 * j]; s += (v[j][0] * v[j][0] + v[j][1] * v[j][1]) + (v[j][2] * v[j][2] + v[j][3] * v[j][3]); }
#pragma unroll
    for (int o = 1; o < 64; o <<= 1) s += __shfl_xor(s, o);
    u32x2* o8 = (u32x2*)orow + lane;
#pragma unroll
    for (int j = 0; j < 4; ++j) { u32x2 w; w.x = cvtpk(v[j][0], v[j][1]); w.y = cvtpk(v[j][2], v[j][3]); o8[64 * j] = w; }
    if (lane == 0 && ss0) { *ss0 = s; *ss1 = 0.f; *ss2 = 0.f; *ss3 = 0.f; }
}
DI void final_row(float* xrow, const float* g, int lane) {
    f32x4* xr = (f32x4*)xrow + lane; const f32x4* gr = (const f32x4*)g + lane; f32x4 v[4]; float s = 0.f;
#pragma unroll
    for (int j = 0; j < 4; ++j) { v[j] = xr[64 * j]; s += (v[j][0] * v[j][0] + v[j][1] * v[j][1]) + (v[j][2] * v[j][2] + v[j][3] * v[j][3]); }
#pragma unroll
    for (int o = 1; o < 64; o <<= 1) s += __shfl_xor(s, o);
    const float rs = 1.0f / sqrtf(s * (1.0f / DM) + EPS);
#pragma unroll
    for (int j = 0; j < 4; ++j) xr[64 * j] = v[j] * rs * gr[64 * j];
}

template <int NT, bool SSQ> DI void sgemm(const bf16* A, int lda, const bf16* Bt, int K, int n0, f32x4 (&acc)[NT], float& ssq, int wave, int lane) {
    const int fr = lane & 15, fq = lane >> 4;
    const bf16* ap = A + (size_t)(16 * wave + fr) * lda + 8 * fq;
    const bf16* bp = Bt + (size_t)(n0 + fr) * K + 8 * fq;
#pragma unroll
    for (int t = 0; t < NT; ++t) acc[t] = (f32x4){0.f, 0.f, 0.f, 0.f};
    float s = 0.f;
#pragma unroll 4
    for (int k = 0; k < K; k += 32) {
        const bf16x8 a = *(const bf16x8*)(ap + k);
#pragma unroll
        for (int t = 0; t < NT; ++t) { const bf16x8 b = *(const bf16x8*)(bp + (size_t)t * 16 * K + k); acc[t] = MFMA16(b, a, acc[t]); }
        if (SSQ) {
#pragma unroll
            for (int j = 0; j < 8; ++j) { const float f = b2f((unsigned short)a[j]); s += f * f; } }
    }
    if (SSQ) { s += __shfl_xor(s, 16); s += __shfl_xor(s, 32); }
    ssq = s;
}
constexpr int SIN_ITEMS = NIN / 32, SOUT_ITEMS = DM / 16;
DI void sin_item(int it, const bf16* XB, const bf16* WinT, bf16* PROJ, float* LA, const float* bup, int wave, int lane) {
    f32x4 acc[2]; float ssq; const int n0 = it * 32;
    sgemm<2, true>(XB + (size_t)MP * DM, DM, WinT, DM, n0, acc, ssq, wave, lane);
    const int fr = lane & 15, fq = lane >> 4, row = MP + 16 * wave + fr, kind = in_kind(n0 >> 8);
    const float rs = 1.0f / sqrtf(ssq * (1.0f / DM) + EPS);
#pragma unroll
    for (int t = 0; t < 2; ++t) { const int col = n0 + 16 * t + 4 * fq; f32x4 v = acc[t] * rs;
        if (kind == 5) { const f32x4 bv = *(const f32x4*)(bup + col - 4352); f32x4 o;
#pragma unroll
            for (int i = 0; i < 4; ++i) o[i] = logsig_f(v[i] + bv[i]) * 0.0625f;
            *(f32x4*)(LA + (size_t)row * 256 + col - 4352) = o; }
        else {
#pragma unroll
            for (int i = 0; i < 4; ++i) v[i] = in_xform(v[i], kind);
            u32x2 w; w.x = cvtpk(v[0], v[1]); w.y = cvtpk(v[2], v[3]); *(u32x2*)(PROJ + (size_t)row * LDP + col) = w; } }
}
DI void sout_item(int it, const bf16* Y, const bf16* WoutT, const float* xold, float* xnew, bf16* XB, int wave, int lane) {
    f32x4 acc[1]; float ssq; const int n0 = it * 16;
    sgemm<1, false>(Y + (size_t)MP * DMIX, DMIX, WoutT, DMIX, n0, acc, ssq, wave, lane);
    const int fr = lane & 15, fq = lane >> 4, rs = 16 * wave + fr, col = n0 + 4 * fq;
    const f32x4 xn = *(const f32x4*)(xold + (size_t)rs * DM + col) + acc[0];
    *(f32x4*)(xnew + (size_t)rs * DM + col) = xn;
    u32x2 w; w.x = cvtpk(xn[0], xn[1]); w.y = cvtpk(xn[2], xn[3]); *(u32x2*)(XB + (size_t)(MP + rs) * DM + col) = w;
}

constexpr int GLA_ITEMS = 2 * 128 * 4, KSTR = 144, VSTR = 272;
DI void gla_cumsum(const float* LA, int row0, int h, LAS float* SEG, int tid, float (&a)[8], float& off, float& bl) {
    const int d = tid & 63, seg = tid >> 6;
#pragma unroll
    for (int i = 0; i < 8; ++i) a[i] = LA[(size_t)(row0 + seg * 8 + i) * 256 + h * 64 + d];
#pragma unroll
    for (int i = 1; i < 8; ++i) a[i] += a[i - 1];
    SEG[seg * 64 + d] = a[7];
    WG_SYNC();
    off = 0.f; bl = 0.f;
#pragma unroll
    for (int s = 0; s < 8; ++s) { const float v = SEG[s * 64 + d]; bl += v; if (s < seg) off += v; }
}
DI void gla1_item(int it, const bf16* PROJ, const float* LA, float* DS, float* AG, ldsp lds, int tid, int wave, int lane) {
    const int h = it & 3, row0 = (it >> 2) * 64, d = tid & 63, seg = tid >> 6;
    LAS float* SEG = (LAS float*)lds; ldsp KD = lds + 2048, V = lds + 2048 + 64 * KSTR;
#pragma unroll
    for (int i = 0; i < 2; ++i) { const int c = tid + 512 * i, r = c >> 4, p = c & 15;
        *(LAS v4u*)(V + r * VSTR + p * 16) = *(const v4u*)(PROJ + (size_t)(row0 + r) * LDP + C_VC + h * 128 + p * 8); }
    float a[8], off, bl; gla_cumsum(LA, row0, h, SEG, tid, a, off, bl);
#pragma unroll
    for (int i = 0; i < 8; ++i) { const int t = seg * 8 + i; const float b = a[i] + off;
        const float k = b2f(PROJ[(size_t)(row0 + t) * LDP + C_KC + h * 64 + d]);
        *(LAS unsigned short*)(KD + t * KSTR + d * 2) = f2b(k * __expf(bl - b)); }
    if (seg == 0) AG[(size_t)it * 64 + d] = __expf(bl);
    WG_SYNC();
    const int dt = wave & 1, vt = wave >> 1, hh = lane >> 5;
    f32x16 acc = {};
#pragma unroll
    for (int ks = 0; ks < 4; ++ks) { const int k0 = 16 * ks + 8 * hh;
        const bf16x8 A = trfrag(KD, KSTR, k0, k0 + 4, 32 * dt, lane), B = trfrag(V, VSTR, k0, k0 + 4, 32 * vt, lane);
        acc = MFMA32(A, B, acc); }
    float* dst = DS + (size_t)it * 8192 + 32 * vt + (lane & 31);
#pragma unroll
    for (int r = 0; r < 16; ++r) dst[(32 * dt + crow(r, hh)) * 128] = acc[r];
    WG_SYNC();
}
constexpr int SCAN_ITEMS = 2 * 4 * 16;
DI void scan_item(int it, float* DS, const float* AG, float* gout  , int tid) {
    const int bh = it >> 4, part = it & 15, b = bh >> 2, h = bh & 3, e = part * 512 + tid, d = e >> 7;
    float S = 0.f;
    for (int n0 = 0; n0 < 128; n0 += 8) {
        float ds[8], ag[8];
#pragma unroll
        for (int j = 0; j < 8; ++j) { const size_t idx = (size_t)((b * 128 + n0 + j) * 4 + h); ds[j] = DS[idx * 8192 + e]; ag[j] = AG[idx * 64 + d]; }
#pragma unroll
        for (int j = 0; j < 8; ++j) { const size_t idx = (size_t)((b * 128 + n0 + j) * 4 + h); DS[idx * 8192 + e] = S; S = ag[j] * S + ds[j]; }
    }
    gout[(size_t)(b * 4 + h) * 8192 + e] = S;
}
DI void gla2_item(int it, const bf16* PROJ, const float* LA, const float* DS, const float* gn, bf16* Y, ldsp lds, int tid, int wave, int lane) {
    const int h = it & 3, row0 = (it >> 2) * 64, d = tid & 63, seg = tid >> 6;
    LAS float* SEG = (LAS float*)lds; ldsp QD = lds + 2048, KI = QD + 64 * KSTR, V = KI + 64 * KSTR, SP = V + 64 * VSTR; LAS float* SS = (LAS float*)(SP + 64 * VSTR);
#pragma unroll
    for (int i = 0; i < 2; ++i) { const int c = tid + 512 * i, r = c >> 4, p = c & 15;
        *(LAS v4u*)(V + r * VSTR + p * 16) = *(const v4u*)(PROJ + (size_t)(row0 + r) * LDP + C_VC + h * 128 + p * 8); }
#pragma unroll
    for (int i = 0; i < 4; ++i) { const int c = tid + 512 * i, r = c >> 5, p = c & 31; const f32x4 s = *(const f32x4*)(DS + (size_t)it * 8192 + r * 128 + p * 4);
        u32x2 w; w.x = cvtpk(s[0], s[1]); w.y = cvtpk(s[2], s[3]); *(LAS u32x2*)(SP + r * VSTR + p * 8) = w; }
    float a[8], off, bl; gla_cumsum(LA, row0, h, SEG, tid, a, off, bl);
#pragma unroll
    for (int i = 0; i < 8; ++i) { const int t = seg * 8 + i; const float b = a[i] + off;
        const float q = b2f(PROJ[(size_t)(row0 + t) * LDP + C_QC + h * 64 + d]), k = b2f(PROJ[(size_t)(row0 + t) * LDP + C_KC + h * 64 + d]);
        *(LAS unsigned short*)(QD + t * KSTR + d * 2) = f2b(q * __expf(b));
        *(LAS unsigned short*)(KI + t * KSTR + d * 2) = f2b(k * __expf(-b)); }
    WG_SYNC();
    const int qi = wave & 1, vt = wave >> 1, hh = lane >> 5, r = lane & 31;
    bf16x8 Qf[4];
#pragma unroll
    for (int ks = 0; ks < 4; ++ks) Qf[ks] = lds16(QD + (32 * qi + r) * KSTR + (16 * ks + 8 * hh) * 2);
    f32x16 acc = {};
#pragma unroll
    for (int ks = 0; ks < 4; ++ks) { const int k0 = 16 * ks + 8 * hh; acc = MFMA32(trfrag(SP, VSTR, k0, k0 + 4, 32 * vt, lane), Qf[ks], acc); }
    for (int si = 0; si <= qi; ++si) {
        f32x16 X = {};
#pragma unroll
        for (int ks = 0; ks < 4; ++ks) X = MFMA32(lds16(KI + (32 * si + r) * KSTR + (16 * ks + 8 * hh) * 2), Qf[ks], X);
        if (si == qi) {
#pragma unroll
            for (int g = 0; g < 16; ++g) if (crow(g, hh) > r) X[g] = 0.f; }
#pragma unroll
        for (int s2 = 0; s2 < 2; ++s2) { const int k0 = 32 * si + 16 * s2 + 4 * hh;
            acc = MFMA32(trfrag(V, VSTR, k0, k0 + 8, 32 * vt, lane), pack8(X, s2), acc); }
    }
    float ss = 0.f;
#pragma unroll
    for (int g = 0; g < 16; ++g) ss += acc[g] * acc[g];
    ss += __shfl_xor(ss, 32);
    if (hh == 0) SS[wave * 32 + r] = ss;
    WG_SYNC();
    const float tot = (SS[qi * 32 + r] + SS[(qi + 2) * 32 + r]) + (SS[(qi + 4) * 32 + r] + SS[(qi + 6) * 32 + r]);
    const float rs = 1.0f / sqrtf(tot * (1.0f / 128.0f) + EPS);
    const size_t row = (size_t)(row0 + 32 * qi + r);
#pragma unroll
    for (int g = 0; g < 4; ++g) { const int dv0 = h * 128 + 32 * vt + 8 * g + 4 * hh;
        const u32x2 gt = *(const u32x2*)(PROJ + row * LDP + C_GC + dv0); const f32x4 gw = *(const f32x4*)(gn + dv0);
        u32x2 w; w.x = cvtpk(acc[4 * g] * rs * gw[0] * blo(gt.x), acc[4 * g + 1] * rs * gw[1] * bhi(gt.x)); w.y = cvtpk(acc[4 * g + 2] * rs * gw[2] * blo(gt.y), acc[4 * g + 3] * rs * gw[3] * bhi(gt.y));
        *(u32x2*)(Y + row * DMIX + 1024 + dv0) = w; }
    WG_SYNC();
}

constexpr int SWA_ITEMS = 2 * 64 * 2;
constexpr float NEGL = -1e30f;
DI void swa_item(int it, const bf16* PROJ, const float* rel_bias, const float* sink, bf16* Y, ldsp lds, int tid, int wave, int lane) {
    const int kv = it & 1, bq = it >> 1, qb = bq & 63, tok0 = bq * 128;
    ldsp K = lds, V = lds + 256 * KSTR; LAS float* BT = (LAS float*)(V + 256 * KSTR);
#pragma unroll
    for (int i = 0; i < 4; ++i) { const int c = tid + 512 * i, j = c >> 3, p = c & 7; v4u kk = {0u, 0u, 0u, 0u}, vv = {0u, 0u, 0u, 0u};
        if (qb > 0 || j >= 128) { const bf16* src = PROJ + (size_t)(tok0 - 128 + j) * LDP + kv * 64 + p * 8; kk = *(const v4u*)(src + C_KA); vv = *(const v4u*)(src + C_VA); }
        *(LAS v4u*)(K + j * KSTR + p * 16) = kk; *(LAS v4u*)(V + j * KSTR + p * 16) = vv; }
    { const int g = tid >> 7, dist = tid & 127; BT[tid] = rel_bias[T5_BUCKET[dist] * 8 + kv * 4 + g] * LOG2E; }
    WG_SYNC();
    const int g = wave >> 1, head = kv * 4 + g, hh = lane >> 5, r = lane & 31;
    const float snk = sink[head] * LOG2E;
    for (int qq = 0; qq < 2; ++qq) {
        const int qg = 2 * (wave & 1) + qq; const size_t qrow = (size_t)(tok0 + 32 * qg + r);
        bf16x8 Qf[4];
#pragma unroll
        for (int ks = 0; ks < 4; ++ks) Qf[ks] = *(const bf16x8*)(PROJ + qrow * LDP + C_QA + head * 64 + 16 * ks + 8 * hh);
        f32x16 S[5];
#pragma unroll
        for (int t = 0; t < 5; ++t) { S[t] = (f32x16){};
#pragma unroll
            for (int ks = 0; ks < 4; ++ks) S[t] = MFMA32(lds16(K + (32 * (qg + t) + r) * KSTR + (16 * ks + 8 * hh) * 2), Qf[ks], S[t]); }
        float mx = snk;
#pragma unroll
        for (int t = 0; t < 5; ++t)
#pragma unroll
            for (int x = 0; x < 16; ++x) { const int cr = crow(x, hh), j = 32 * (qg + t) + cr, dist = 128 + r - 32 * t - cr;
                bool ok = (qb > 0 || j >= 128); if (t == 0) ok = ok && (cr > r); if (t == 4) ok = ok && (cr <= r);
                const float lg = ok ? S[t][x] + BT[g * 128 + (dist & 127)] : NEGL; S[t][x] = lg; mx = fmaxf(mx, lg); }
        mx = fmaxf(mx, __shfl_xor(mx, 32));
        float l = 0.f;
#pragma unroll
        for (int t = 0; t < 5; ++t)
#pragma unroll
            for (int x = 0; x < 16; ++x) { const float p = __builtin_amdgcn_exp2f(S[t][x] - mx); S[t][x] = p; l += p; }
        l += __shfl_xor(l, 32); l += __builtin_amdgcn_exp2f(snk - mx);
        const float inv = 1.0f / l;
        f32x16 O[2] = {(f32x16){}, (f32x16){}};
#pragma unroll
        for (int t = 0; t < 5; ++t)
#pragma unroll
            for (int s2 = 0; s2 < 2; ++s2) { const bf16x8 P = pack8(S[t], s2); const int k0 = 32 * (qg + t) + 16 * s2 + 4 * hh;
#pragma unroll
                for (int dt = 0; dt < 2; ++dt) O[dt] = MFMA32(trfrag(V, KSTR, k0, k0 + 8, 32 * dt, lane), P, O[dt]); }
#pragma unroll
        for (int dt = 0; dt < 2; ++dt)
#pragma unroll
            for (int gq = 0; gq < 4; ++gq) { const int c0 = head * 64 + 32 * dt + 8 * gq + 4 * hh; const u32x2 gt = *(const u32x2*)(PROJ + qrow * LDP + C_GA + c0);
                u32x2 w; w.x = cvtpk(O[dt][4 * gq] * inv * blo(gt.x), O[dt][4 * gq + 1] * inv * bhi(gt.x)); w.y = cvtpk(O[dt][4 * gq + 2] * inv * blo(gt.y), O[dt][4 * gq + 3] * inv * bhi(gt.y));
                *(u32x2*)(Y + qrow * DMIX + c0) = w; }
    }
    WG_SYNC();
}

constexpr int GMLP_ITEMS = 2 * 64 * 8;
DI void gmlp_item(int it, const bf16* PROJ, const float* Ws  , const float* bs  , const float* lng, const float* lnb, bf16* Y, ldsp lds, int tid, int wave, int lane) {
    const int hd = it & 7, tok0 = (it >> 3) * 128;
    ldsp WS = lds, VN = lds + 128 * VSTR; LAS float* ST = (LAS float*)(VN + 128 * KSTR);
    { const int t = tid >> 2, part = tid & 3; const bf16* src = PROJ + (size_t)(tok0 + t) * LDP + C_VB + part * 128; float s1 = 0.f, s2 = 0.f;
#pragma unroll
        for (int i = 0; i < 16; ++i) { const v4u w = *(const v4u*)(src + i * 8);
#pragma unroll
            for (int e = 0; e < 4; ++e) { const float x0 = blo(w[e]), x1 = bhi(w[e]); s1 += x0 + x1; s2 += x0 * x0 + x1 * x1; } }
        s1 += __shfl_xor(s1, 1); s2 += __shfl_xor(s2, 1); s1 += __shfl_xor(s1, 2); s2 += __shfl_xor(s2, 2);
        const float mu = s1 * (1.0f / 512.0f), var = fmaxf(s2 * (1.0f / 512.0f) - mu * mu, 0.f);
        if (part == 0) { ST[2 * t] = mu; ST[2 * t + 1] = 1.0f / sqrtf(var + EPS); } }
    { const float* wsrc = Ws + (size_t)hd * 16384;
#pragma unroll
        for (int ii = 0; ii < 8; ++ii) { const int idx = tid + 512 * ii, i = idx >> 5, j4 = (idx & 31) * 4; const f32x4 w = *(const f32x4*)(wsrc + i * 128 + j4);
            u32x2 o; o.x = cvtpk(j4 <= i ? w[0] : 0.f, j4 + 1 <= i ? w[1] : 0.f); o.y = cvtpk(j4 + 2 <= i ? w[2] : 0.f, j4 + 3 <= i ? w[3] : 0.f);
            *(LAS u32x2*)(WS + i * VSTR + j4 * 2) = o; } }
    WG_SYNC();
#pragma unroll
    for (int ii = 0; ii < 2; ++ii) { const int idx = tid + 512 * ii, t = idx >> 3, c8 = (idx & 7) * 8; const float mu = ST[2 * t], rs = ST[2 * t + 1];
        const v4u w = *(const v4u*)(PROJ + (size_t)(tok0 + t) * LDP + C_VB + hd * 64 + c8); const float* gp = lng + hd * 64 + c8; const float* bp = lnb + hd * 64 + c8; v4u o;
#pragma unroll
        for (int e = 0; e < 4; ++e) o[e] = cvtpk((blo(w[e]) - mu) * rs * gp[2 * e] + bp[2 * e], (bhi(w[e]) - mu) * rs * gp[2 * e + 1] + bp[2 * e + 1]);
        *(LAS v4u*)(VN + t * KSTR + c8 * 2) = o; }
    WG_SYNC();
    const int ct = wave & 1, itl = wave >> 1, hh = lane >> 5, r = lane & 31;
    f32x16 acc = {};
    for (int ks = 0; ks < 2 * (itl + 1); ++ks) { const int k0 = 16 * ks + 8 * hh;
        acc = MFMA32(trfrag(VN, KSTR, k0, k0 + 4, 32 * ct, lane), lds16(WS + (32 * itl + r) * VSTR + k0 * 2), acc); }
    const size_t row = (size_t)(tok0 + 32 * itl + r); const float bias = bs[hd * 128 + 32 * itl + r];
#pragma unroll
    for (int g = 0; g < 4; ++g) { const int c0 = hd * 64 + 32 * ct + 8 * g + 4 * hh;
        const u32x2 u = *(const u32x2*)(PROJ + row * LDP + C_UB + c0), gt = *(const u32x2*)(PROJ + row * LDP + C_GB + c0);
        u32x2 w; w.x = cvtpk(blo(u.x) * (acc[4 * g] + bias) * blo(gt.x), bhi(u.x) * (acc[4 * g + 1] + bias) * bhi(gt.x));
        w.y = cvtpk(blo(u.y) * (acc[4 * g + 2] + bias) * blo(gt.y), bhi(u.y) * (acc[4 * g + 3] + bias) * bhi(gt.y));
        *(u32x2*)(Y + row * DMIX + 512 + c0) = w; }
    WG_SYNC();
}

constexpr int SSWA_ITEMS = 128;
DI void sswa_item(int bd, const bf16* PROJ, const float* stK, const float* stV, const float* rel_bias, const float* sink, float* outK, float* outV, bf16* Y, ldsp lds, int tid, int wave, int lane) {
    const size_t row = (size_t)(MP + bd);
    LAS float* Q = (LAS float*)lds;
    LAS float* KN = Q + 512;
    LAS float* VNW = KN + 128;
    LAS float* SC = VNW + 128;
    LAS float* RED = SC + 1024;
    Q[tid] = b2f(PROJ[row * LDP + C_QA + tid]);
    if (tid < 128) KN[tid] = b2f(PROJ[row * LDP + C_KA + tid]); else if (tid < 256) VNW[tid - 128] = b2f(PROJ[row * LDP + C_VA + tid - 128]);
    WG_SYNC();
    const int p = tid & 31, kvh = p >> 4, d4 = (p & 15) * 4, rg = tid >> 5;
    const float* ksrc = stK + (size_t)bd * 16384; const float* vsrc = stV + (size_t)bd * 16384; float* kdst = outK + (size_t)bd * 16384; float* vdst = outV + (size_t)bd * 16384;
#pragma unroll
    for (int i = 0; i < 8; ++i) { const int jj = rg + 16 * i; f32x4 kvec;
        if (jj < 127) kvec = *(const f32x4*)(ksrc + (jj + 1) * 128 + p * 4); else { kvec[0] = KN[p * 4]; kvec[1] = KN[p * 4 + 1]; kvec[2] = KN[p * 4 + 2]; kvec[3] = KN[p * 4 + 3]; }
        *(f32x4*)(kdst + jj * 128 + p * 4) = kvec;
        float s[4];
#pragma unroll
        for (int g = 0; g < 4; ++g) { const LAS float* qp = Q + (kvh * 4 + g) * 64 + d4; s[g] = (kvec[0] * qp[0] + kvec[1] * qp[1]) + (kvec[2] * qp[2] + kvec[3] * qp[3]); }
#pragma unroll
        for (int o = 1; o < 16; o <<= 1) {
#pragma unroll
            for (int g = 0; g < 4; ++g) s[g] += __shfl_xor(s[g], o); }
        if ((p & 15) == 0) {
#pragma unroll
            for (int g = 0; g < 4; ++g) SC[(kvh * 4 + g) * 128 + jj] = s[g] + rel_bias[T5_BUCKET[127 - jj] * 8 + kvh * 4 + g] * LOG2E; } }
    WG_SYNC();
    { const int head = wave; const float snk = sink[head] * LOG2E; const float s0 = SC[head * 128 + lane], s1 = SC[head * 128 + 64 + lane];
        float mx = fmaxf(fmaxf(s0, s1), snk);
#pragma unroll
        for (int o = 1; o < 64; o <<= 1) mx = fmaxf(mx, __shfl_xor(mx, o));
        const float p0 = __builtin_amdgcn_exp2f(s0 - mx), p1 = __builtin_amdgcn_exp2f(s1 - mx); float l = p0 + p1;
#pragma unroll
        for (int o = 1; o < 64; o <<= 1) l += __shfl_xor(l, o);
        l += __builtin_amdgcn_exp2f(snk - mx); const float inv = 1.0f / l;
        SC[head * 128 + lane] = p0 * inv; SC[head * 128 + 64 + lane] = p1 * inv; }
    WG_SYNC();
    float acc[4][4];
#pragma unroll
    for (int g = 0; g < 4; ++g)
#pragma unroll
        for (int c = 0; c < 4; ++c) acc[g][c] = 0.f;
#pragma unroll
    for (int i = 0; i < 8; ++i) { const int jj = rg + 16 * i; f32x4 vvec;
        if (jj < 127) vvec = *(const f32x4*)(vsrc + (jj + 1) * 128 + p * 4); else { vvec[0] = VNW[p * 4]; vvec[1] = VNW[p * 4 + 1]; vvec[2] = VNW[p * 4 + 2]; vvec[3] = VNW[p * 4 + 3]; }
        *(f32x4*)(vdst + jj * 128 + p * 4) = vvec;
#pragma unroll
        for (int g = 0; g < 4; ++g) { const float pr = SC[(kvh * 4 + g) * 128 + jj];
#pragma unroll
            for (int c = 0; c < 4; ++c) acc[g][c] += pr * vvec[c]; } }
#pragma unroll
    for (int g = 0; g < 4; ++g)
#pragma unroll
        for (int c = 0; c < 4; ++c) RED[rg * 512 + (kvh * 4 + g) * 64 + d4 + c] = acc[g][c];
    WG_SYNC();
    { float o = 0.f;
#pragma unroll
        for (int q = 0; q < 16; ++q) o += RED[q * 512 + tid];
        Y[row * DMIX + tid] = f2b(o * b2f(PROJ[row * LDP + C_GA + tid])); }
    WG_SYNC();
}
constexpr int SGMLP_ITEMS = 16;
DI void sgmlp_item(int it, const bf16* PROJ, const float* Ws, const float* bs, const float* lng, const float* lnb, float* cv  , bf16* Y, int wave, int lane) {
    const int bd = it * 8 + wave; const size_t row = (size_t)(MP + bd); const int c0 = lane * 8, hd = lane >> 3;
    const v4u w = *(const v4u*)(PROJ + row * LDP + C_VB + c0); float v[8]; float s1 = 0.f, s2 = 0.f;
#pragma unroll
    for (int e = 0; e < 4; ++e) { v[2 * e] = blo(w[e]); v[2 * e + 1] = bhi(w[e]); }
#pragma unroll
    for (int e = 0; e < 8; ++e) s1 += v[e];
#pragma unroll
    for (int o = 1; o < 64; o <<= 1) s1 += __shfl_xor(s1, o);
    const float mu = s1 * (1.0f / 512.0f);
#pragma unroll
    for (int e = 0; e < 8; ++e) { v[e] -= mu; s2 += v[e] * v[e]; }
#pragma unroll
    for (int o = 1; o < 64; o <<= 1) s2 += __shfl_xor(s2, o);
    const float rs = 1.0f / sqrtf(s2 * (1.0f / 512.0f) + EPS), w00 = Ws[(size_t)hd * 16384], b0 = bs[hd * 128];
    const v4u uu = *(const v4u*)(PROJ + row * LDP + C_UB + c0), gg = *(const v4u*)(PROJ + row * LDP + C_GB + c0); float vn[8]; v4u o;
#pragma unroll
    for (int e = 0; e < 8; ++e) vn[e] = v[e] * rs * lng[c0 + e] + lnb[c0 + e];
    *(f32x4*)(cv + (size_t)bd * 512 + c0) = (f32x4){vn[0], vn[1], vn[2], vn[3]}; *(f32x4*)(cv + (size_t)bd * 512 + c0 + 4) = (f32x4){vn[4], vn[5], vn[6], vn[7]};
#pragma unroll
    for (int e = 0; e < 4; ++e) o[e] = cvtpk(blo(uu[e]) * (w00 * vn[2 * e] + b0) * blo(gg[e]), bhi(uu[e]) * (w00 * vn[2 * e + 1] + b0) * bhi(gg[e]));
    *(v4u*)(Y + row * DMIX + 512 + c0) = o;
}
constexpr int SGLA_ITEMS = 512;
DI void sgla_item(int it, const bf16* PROJ, const float* LA, const float* st0  , const float* gn, float* sout  , bf16* Y, ldsp lds, int tid, int wave, int lane) {
    const int h = it & 3, bd = it >> 2; const size_t row = (size_t)(MP + bd);
    LAS float* QS = (LAS float*)lds; LAS float* KS = QS + 64; LAS float* AS = KS + 64; LAS float* RED = AS + 64; LAS float* SS = RED + 16 * 128;
    if (tid < 64) { QS[tid] = b2f(PROJ[row * LDP + C_QC + h * 64 + tid]); KS[tid] = b2f(PROJ[row * LDP + C_KC + h * 64 + tid]); AS[tid] = __expf(LA[row * 256 + h * 64 + tid]); }
    const int dv4 = (tid & 31) * 4, dg = tid >> 5;
    const u32x2 vw = *(const u32x2*)(PROJ + row * LDP + C_VC + h * 128 + dv4); const f32x4 vv = {blo(vw.x), bhi(vw.x), blo(vw.y), bhi(vw.y)};
    WG_SYNC();
    const float* s0 = st0 + (size_t)it * 8192; float* so = sout + (size_t)it * 8192;
    f32x4 op = {0.f, 0.f, 0.f, 0.f};
#pragma unroll
    for (int i = 0; i < 4; ++i) { const int d = dg + 16 * i; const f32x4 s = *(const f32x4*)(s0 + d * 128 + dv4); const f32x4 sf = s * AS[d] + vv * KS[d];
        *(f32x4*)(so + d * 128 + dv4) = sf; op += sf * QS[d]; }
    *(LAS f32x4*)(RED + dg * 128 + dv4) = op;
    WG_SYNC();
    float o = 0.f;
    if (tid < 128) {
#pragma unroll
        for (int q = 0; q < 16; ++q) o += RED[q * 128 + tid];
        float ss = o * o;
#pragma unroll
        for (int x = 1; x < 64; x <<= 1) ss += __shfl_xor(ss, x);
        if (lane == 0) SS[wave] = ss; }
    WG_SYNC();
    if (tid < 128) { const float rs = 1.0f / sqrtf((SS[0] + SS[1]) * (1.0f / 128.0f) + EPS);
        Y[row * DMIX + 1024 + h * 128 + tid] = f2b(o * rs * gn[h * 128 + tid] * b2f(PROJ[row * LDP + C_GC + h * 128 + tid])); }
    WG_SYNC();
}
constexpr int NWAVES = 8;
constexpr int NPH = 22;
constexpr int N_LAUNCHES = MK_N_LAUNCHES;
static_assert(N_LAUNCHES == 1 || N_LAUNCHES == NPH, "MK_N_LAUNCHES is 1 or 22");
constexpr size_t MiB = 1u << 20;
constexpr size_t WS_CTL = 0, CTL_ZERO_BYTES = 65536;
constexpr size_t WS_WIN = 1 * MiB;
constexpr size_t WS_WOUT = 10 * MiB;
constexpr size_t WS_XB = 13 * MiB;
constexpr size_t WS_PROJ = 46 * MiB;
constexpr size_t WS_LA = 184 * MiB;
constexpr size_t WS_Y = 201 * MiB;
constexpr size_t WS_DS = 250 * MiB;
constexpr size_t WS_AG = 282 * MiB;
constexpr size_t WS_ROWSS = WS_AG + MiB / 2;
constexpr size_t WS_END = 283 * MiB;
static_assert(WS_XB + (size_t)MT * DM * 2 <= WS_PROJ && WS_PROJ + (size_t)MT * LDP * 2 <= WS_LA && WS_LA + (size_t)MT * 256 * 4 <= WS_Y && WS_Y + (size_t)MT * DMIX * 2 <= WS_DS && WS_ROWSS + (size_t)4 * MT * 4 <= WS_END, "d_ws map");
constexpr int CW_BAR = 4096;
static_assert(WSO_XB == WS_XB && WSO_PROJ == WS_PROJ && WSO_LA == WS_LA && WSO_ROWSS == WS_ROWSS, "header copies of the d_ws map");
static_assert((CW_BAR + XCD_BAR_WORDS) * 4 <= (int)CTL_ZERO_BYTES, "barrier words inside the memset region");
static_assert(true, "");
constexpr size_t O_YP = 0, O_YS = 16777216, O_KP = 16908288, O_VP = 17039360, O_GP = 17170432, O_KS = 17432576, O_VS = 25821184, O_GS = 34209792, O_CV = 50987008, O_END = 51249152;
constexpr int RING_BYTES = 131072, LDSCTL_OFF = RING_BYTES, MISC_OFF = LDSCTL_OFF + 320, LDS_BYTES = 147456;

__global__ void __launch_bounds__(NWAVES * 64, 2) hymba_fwd(Args args) {
    extern __shared__ __attribute__((aligned(16))) unsigned char lds_raw[];
    ldsp lds = (ldsp)lds_raw;
    volatile LAS unsigned* MISC = (volatile LAS unsigned*)(lds + MISC_OFF);
    const int tid0 = threadIdx.x;
    const int G0 = gridDim.x, bx0 = blockIdx.x, vcu0 = (G0 % 8 == 0) ? (bx0 % 8) * (G0 / 8) + bx0 / 8 : bx0;
#define PHASE_LOCALS int tid = tid0, G = G0, bx = bx0, vcu = vcu0; asm volatile("" : "+v"(tid), "+s"(G), "+s"(bx), "+s"(vcu)); const int lane = tid & 63, wave = __builtin_amdgcn_readfirstlane(tid >> 6); (void)lane; (void)wave; (void)bx; (void)vcu; (void)G;
    gu32* ctl = (gu32*)(KA()->ws + WS_CTL);
#define x_prompt (KA()->in[0])
#define x_sample (KA()->in[1])
#define st_k (KA()->in[2])
#define st_v (KA()->in[3])
#define st_g (KA()->in[4])
#define rel_bias (KA()->in[5])
#define norm_g (KA()->in[6])
#define w_in (KA()->in[7])
#define sinks (KA()->in[8])
#define sp_w (KA()->in[9])
#define sp_b (KA()->in[10])
#define ln_g (KA()->in[11])
#define ln_b (KA()->in[12])
#define w_up (KA()->in[13])
#define b_up (KA()->in[14])
#define gla_gn (KA()->in[15])
#define w_out (KA()->in[16])
#define fin_g (KA()->in[17])
#define out (KA()->out)
#define WIN ((bf16*)(KA()->ws + WS_WIN))
#define WOUT ((bf16*)(KA()->ws + WS_WOUT))
#define XB ((bf16*)(KA()->ws + WS_XB))
#define PROJ ((bf16*)(KA()->ws + WS_PROJ))
#define LAB ((float*)(KA()->ws + WS_LA))
#define Y ((bf16*)(KA()->ws + WS_Y))
#define DS ((float*)(KA()->ws + WS_DS))
#define AG ((float*)(KA()->ws + WS_AG))
#define ROWSS ((float*)(KA()->ws + WS_ROWSS))
    for (int u = tid0; u < (LDS_BYTES - LDSCTL_OFF) / 4; u += NWAVES * 64) ((LAS unsigned*)(lds + LDSCTL_OFF))[u] = 0u;
    __syncthreads();
    XcdBarrier bar; bar.bar = (unsigned*)(ctl + CW_BAR); bar.x = 0; bar.st = nullptr;
    if (N_LAUNCHES == 1) bar = xcd_barrier_post((unsigned*)(ctl + CW_BAR), MISC + 8);
    const int lo = KA()->ph_lo, hi = KA()->ph_hi;
#ifndef DISMASK
#define DISMASK 0
#endif
#define IN(k) (lo <= (k) && (k) < hi)
#define EN(b) (!((DISMASK >> (b)) & 1))
#define SEAM(k) do { if (IN(k) && IN((k) + 1)) xcd_barrier(bar); } while (0)

    if (IN(0) && EN(0)) { PHASE_LOCALS
        int it = vcu;
        for (; it < CONV_IN_ITEMS; it += G) conv_in_item(it, w_in, w_up, norm_g, WIN, lds, wave, lane);
        it -= CONV_IN_ITEMS;
        for (; it < MT / 8; it += G) { const int row = it * 8 + wave;
            if (row < MP) row_to_bf16(x_prompt + (size_t)row * DM, XB + (size_t)row * DM, ROWSS + row, ROWSS + MT + row, ROWSS + 2 * MT + row, ROWSS + 3 * MT + row, lane);
            else row_to_bf16(x_sample + (size_t)(row - MP) * DM, XB + (size_t)row * DM, nullptr, nullptr, nullptr, nullptr, lane); }
        __syncthreads();
    }
    SEAM(0);

    for (int l = 0; l < DEPTH; ++l) {
        const int pb = 1 + 5 * l;
        if (IN(pb) && EN(1)) { PHASE_LOCALS
            pg8::Gemm g{XB, WIN, MP, NIN, DM}; pg8::StaticOrder S; S.init(MP, NIN, G, bx);
            pg8::EpiIn E{l};
            pg8::gemm_phase<pg8::EpiIn, pg8::StaticOrder, true, true>(lds, g, S, E);
            { const int nwg = (MP / 256) * (NIN / 256), base = nwg % G; int it, st; if (base == 0) { it = bx; st = G; } else if (bx >= base) { it = bx - base; st = G - base; } else { it = SIN_ITEMS; st = 1; }
              for (; it < SIN_ITEMS; it += st) sin_item(it, XB, WIN, PROJ, LAB, b_up + l * 256, wave, lane); }
            __syncthreads();
        }
        SEAM(pb);
        if (IN(pb + 1) && EN(2)) { PHASE_LOCALS
            int it = vcu;
            for (; it < GLA_ITEMS; it += G) gla1_item(it, PROJ, LAB, DS, AG, lds, tid, wave, lane);
            it -= GLA_ITEMS;
            for (; it < SSWA_ITEMS; it += G) sswa_item(it, PROJ, st_k + (size_t)l * 2097152, st_v + (size_t)l * 2097152, rel_bias, sinks + l * 8, out + O_KS + (size_t)l * 2097152, out + O_VS + (size_t)l * 2097152, Y, lds, tid, wave, lane);
            it -= SSWA_ITEMS;
            for (; it < SGLA_ITEMS; it += G) sgla_item(it, PROJ, LAB, st_g + (size_t)l * 4194304, gla_gn + l * 512, out + O_GS + (size_t)l * 4194304, Y, lds, tid, wave, lane);
            it -= SGLA_ITEMS;
            for (; it < SGMLP_ITEMS; it += G) sgmlp_item(it, PROJ, sp_w + (size_t)l * 131072, sp_b + l * 1024, ln_g + l * 512, ln_b + l * 512, out + O_CV + (size_t)l * 65536, Y, wave, lane);
            it -= SGMLP_ITEMS;
            __syncthreads();
            for (; it < CONV_OUT_ITEMS; it += G) conv_out_item(it, w_out + (size_t)l * DMIX * DM, WOUT, lds, wave, lane);
            it -= CONV_OUT_ITEMS;
            if (l + 1 < DEPTH) for (; it < CONV_IN_ITEMS; it += G) conv_in_item(it, w_in + (size_t)(l + 1) * DM * DIN_RAW, w_up + (l + 1) * 4096, norm_g + (l + 1) * DM, WIN, lds, wave, lane);
            __syncthreads();
        }
        SEAM(pb + 1);
        if (IN(pb + 2) && EN(3)) { PHASE_LOCALS
            int it = vcu;
            for (; it < SCAN_ITEMS; it += G) scan_item(it, DS, AG, out + O_GP + (size_t)l * 65536, tid);
            it -= SCAN_ITEMS;
            for (; it < SWA_ITEMS; it += G) swa_item(it, PROJ, rel_bias, sinks + l * 8, Y, lds, tid, wave, lane);
            it -= SWA_ITEMS;
            for (; it < GMLP_ITEMS; it += G) gmlp_item(it, PROJ, sp_w + (size_t)l * 131072, sp_b + l * 1024, ln_g + l * 512, ln_b + l * 512, Y, lds, tid, wave, lane);
            __syncthreads();
        }
        SEAM(pb + 2);
        if (IN(pb + 3) && EN(4)) { PHASE_LOCALS
            for (int it = vcu; it < GLA_ITEMS; it += G) gla2_item(it, PROJ, LAB, DS, gla_gn + l * 512, Y, lds, tid, wave, lane);
            __syncthreads();
        }
        SEAM(pb + 3);
        if (IN(pb + 4) && EN(5)) { PHASE_LOCALS
            pg8::Gemm g{Y, WOUT, MP, DM, DMIX}; pg8::StaticOrder S; S.init(MP, DM, G, bx);
            pg8::EpiOut E{l};
            pg8::gemm_phase<pg8::EpiOut, pg8::StaticOrder, false, true>(lds, g, S, E);
            if ((bx & 3) == 0) for (int it = bx >> 2; it < SOUT_ITEMS; it += (G + 3) >> 2) sout_item(it, Y, WOUT, l == 0 ? x_sample : out + O_YS, out + O_YS, XB, wave, lane);
            __syncthreads();
        }
        SEAM(pb + 4);
    }
    if (IN(NPH - 1) && EN(6)) { PHASE_LOCALS
        for (int it = vcu; it < MT / 8; it += G) final_row(out + O_YP + (size_t)(it * 8 + wave) * DM, fin_g, lane);
    }
#undef IN
#undef SEAM
#undef out
}

extern "C" void kernel_launch(void* const* d_in, const int* in_sizes, int n_in, void* d_out, int out_size, void* d_ws, size_t ws_size, hipStream_t stream) {
    static int grid = 0;
    if (grid == 0) {
        if (n_in != 18 || in_sizes[0] != MP * DM || (size_t)out_size != O_END || ws_size < WS_END) {
            fprintf(stderr, "kernel_launch: shape mismatch: n_in %d in0 %d out %d ws %zu (need >= %zu)\n", n_in, n_in > 0 ? in_sizes[0] : -1, out_size, ws_size, (size_t)WS_END); grid = -1; return; }
        int dev = 0, cus = 0, per_cu = 0;
        if (hipGetDevice(&dev) != hipSuccess || hipDeviceGetAttribute(&cus, hipDeviceAttributeMultiprocessorCount, dev) != hipSuccess) { fprintf(stderr, "kernel_launch: device query failed\n"); grid = -1; return; }
        if (hipFuncSetAttribute((const void*)hymba_fwd, hipFuncAttributeMaxDynamicSharedMemorySize, LDS_BYTES) != hipSuccess) { fprintf(stderr, "kernel_launch: hipFuncSetAttribute failed\n"); grid = -1; return; }
        if (hipOccupancyMaxActiveBlocksPerMultiprocessor(&per_cu, (const void*)hymba_fwd, NWAVES * 64, LDS_BYTES) != hipSuccess || per_cu < 1) { fprintf(stderr, "kernel_launch: occupancy query says %d blocks per CU\n", per_cu); (void)hipGetLastError(); grid = -1; return; }
        (void)hipGetLastError();
        grid = cus;
        if (grid != 256) { fprintf(stderr, "kernel_launch: built for 256 CUs, device has %d\n", cus); grid = -1; return; }
    }
    if (grid < 0) return;
    if (hipMemsetAsync((char*)d_ws + WS_CTL, 0, CTL_ZERO_BYTES, stream) != hipSuccess) { fprintf(stderr, "kernel_launch: memset failed\n"); return; }
    Args a{};
    for (int i = 0; i < 18; ++i) a.in[i] = (const float*)d_in[i];
    a.out = (float*)d_out; a.ws = (unsigned char*)d_ws;
    for (int li = 0; li < N_LAUNCHES; ++li) {
        a.ph_lo = (N_LAUNCHES == 1) ? 0 : li; a.ph_hi = (N_LAUNCHES == 1) ? NPH : li + 1; a.li = li; a.pad = 0;
        hipLaunchKernelGGL(hymba_fwd, dim3(grid), dim3(NWAVES * 64), LDS_BYTES, stream, a);
        const hipError_t le = hipPeekAtLastError();
        if (le != hipSuccess) { fprintf(stderr, "kernel_launch: launch %d failed: %s\n", li, hipGetErrorName(le)); break; }
    }
}
```

```cpp
#include <hip/hip_runtime.h>
#include <cstdio>
#include <cstdint>
#ifndef REPMASK
#define REPMASK 0
#endif
#ifndef MK_N_LAUNCHES
#define MK_N_LAUNCHES 1
#endif
constexpr int MP = 16384, MS = 128, MT = MP + MS, DM = 1024, NIN = 4608, LDP = 4352, DMIX = 1536, SEQ = 8192, DEPTH = 4;
constexpr int DIN_RAW = 4368;
constexpr float EPS = 1e-6f, LOG2E = 1.4426950408889634f, LN2 = 0.6931471805599453f;
constexpr int C_QA = 0, C_KA = 512, C_VA = 640, C_GA = 768, C_UB = 1280, C_VB = 1792, C_GB = 2304, C_QC = 2816, C_KC = 3072, C_VC = 3328, C_GC = 3840;
__device__ __forceinline__ float silu_f(float v) { return v * __builtin_amdgcn_rcpf(1.f + __builtin_amdgcn_exp2f(-v * LOG2E)); }
__device__ __forceinline__ float logsig_f(float z) { return fminf(z, 0.f) - LN2 * __builtin_amdgcn_logf(1.f + __builtin_amdgcn_exp2f(-fabsf(z) * LOG2E)); }
__device__ __forceinline__ int in_kind(int pn) { return (pn < 2) ? 2 : (pn == 2) ? 4 : (pn == 3 || pn == 4 || pn == 9 || pn == 10 || pn == 15 || pn == 16) ? 1 : (pn == 11) ? 3 : (pn == 17) ? 5 : 0; }
__device__ __forceinline__ float in_xform(float v, int kind) { return kind == 1 ? silu_f(v) : kind == 2 ? v * (0.125f * LOG2E) : kind == 3 ? v * 0.125f : v; }
constexpr size_t WSO_XB = 13u << 20, WSO_PROJ = 46u << 20, WSO_LA = 184u << 20, WSO_ROWSS = 327680, WSO_VST = 282u << 20;
constexpr size_t OO_KP = 16908288, OO_VP = 17039360;
struct Args { const float* in[18]; float* out; unsigned char* ws; int ph_lo, ph_hi, li, pad; };
typedef const __attribute__((address_space(4))) Args* kargs_t;
__device__ __forceinline__ kargs_t KA() { kargs_t p = (kargs_t)__builtin_amdgcn_kernarg_segment_ptr(); asm volatile("" : "+s"(p)); return p; }
namespace pg8 {
#define PG8_LAS __attribute__((address_space(3)))
typedef unsigned short bf16_t;
typedef short bf16x8 __attribute__((ext_vector_type(8)));
typedef float f32x4 __attribute__((ext_vector_type(4)));
typedef unsigned u32x4 __attribute__((ext_vector_type(4)));
constexpr int BM = 256, BK = 64, HALF = 128, HTB = HALF * BK * 2  , STAGE_BYTES = 8 * HTB, NXCD = 8, WGM = 8;

__host__ __device__ __forceinline__ int lds_byte(int r, int c) { const int st = (r >> 4) * 2 + (c >> 5), rr = r & 15, cc = c & 31, ob = rr * 64 + cc * 2; return st * 1024 + (ob ^ (((ob >> 9) & 1) << 5)); }
__host__ __device__ __forceinline__ void stage_rc(int b, int& R, int& C) { const int st = b / 1024, sb = b % 1024, swz = sb ^ (((sb >> 9) & 1) << 5); R = (st >> 1) * 16 + swz / 64; C = (st & 1) * 32 + (swz % 64) / 2; }
__host__ __device__ __forceinline__ int perm32(int rho) { const int n = rho >> 4, i = rho & 15; return 8 * (i >> 2) + 4 * n + (i & 3); }

struct Unit { int pm, pn; };
struct Gemm { const bf16_t* A; const bf16_t* Bt; int M, N, K; };

struct StaticOrder {
    int nM, nN, nwg, G, c;
    __host__ __device__ void init(int M, int N, int G_, int c_) { nM = M / BM; nN = N / BM; nwg = nM * nN; G = G_; c = c_; }
    __host__ __device__ bool next(int i, Unit& u) const {
        const long L = (long)i * G + c; if (L >= nwg) return false;
        int wgid = (int)L; { const int q = nwg / NXCD, r = nwg % NXCD, xcd = wgid % NXCD, off = wgid / NXCD; wgid = (xcd < r ? xcd * (q + 1) : r * (q + 1) + (xcd - r) * q) + off; }
        const int nig = WGM * nN, gid = wgid / nig, fm = gid * WGM, gsz = (nM - fm) < WGM ? (nM - fm) : WGM;
        u.pm = fm + ((wgid % nig) % gsz); u.pn = (wgid % nig) / gsz; return true;
    }
    __device__ __forceinline__ void a_ready(const Unit&) const {}
    __device__ __forceinline__ void done(const Unit&) const {}
};

__device__ __forceinline__ unsigned cvt_pk_bf16(float lo, float hi) { unsigned r; asm volatile("v_cvt_pk_bf16_f32 %0, %1, %2" : "=v"(r) : "v"(lo), "v"(hi)); return r; }
typedef float f32x2 __attribute__((ext_vector_type(2)));
struct EpiIn {
    static constexpr bool PERM = true, AFTER_DRAIN = false;
    int l; int pm0; PG8_LAS const float* rs_tab;
    __device__ __forceinline__ void operator()(const f32x4 (&acc)[2][2][4][2], const Unit& u, int wr, int wc, int fr, int fq) const { if (REPMASK & 512) { run(acc, u, wr, wc, fr, fq); asm volatile("" ::: "memory"); } run(acc, u, wr, wc, fr, fq); }
    __device__ __forceinline__ void run(const f32x4 (&acc)[2][2][4][2], const Unit& u, int wr, int wc, int fr, int fq) const {
        const kargs_t ka = KA(); unsigned char* const ws = ka->ws;
        bf16_t* const proj = (bf16_t*)(ws + WSO_PROJ); float* const la = (float*)(ws + WSO_LA); float* const vst = (float*)(ws + WSO_VST); const float* const bup = ka->in[14] + l * 256;
        float* const outk = ka->out + OO_KP + (size_t)l * 32768; float* const outv = ka->out + OO_VP + (size_t)l * 32768;
        const int kind = in_kind(u.pn);
        const int row0 = u.pm * BM + wr * 64 + fr, ct = wc * 32 + 8 * fq; PG8_LAS const float* const rsp = rs_tab + (u.pm - pm0) * BM + wr * 64 + fr;
        if (kind == 5) {
            f32x4 bv[2][2];
#pragma unroll
            for (int bj = 0; bj < 2; ++bj)
#pragma unroll
                for (int n = 0; n < 2; ++n) bv[bj][n] = *(const f32x4*)(bup + ct + bj * HALF + 4 * n);
#pragma unroll
            for (int ai = 0; ai < 2; ++ai)
#pragma unroll
                for (int m = 0; m < 4; ++m) { const int r = row0 + ai * HALF + m * 16;
                    const float rs = rsp[ai * HALF + m * 16];
                    float* rowp = la + (size_t)r * 256 + ct;
#pragma unroll
                    for (int bj = 0; bj < 2; ++bj)
#pragma unroll
                        for (int n = 0; n < 2; ++n) { const f32x4 z = acc[ai][bj][m][n] * rs + bv[bj][n]; f32x4 o;
                            o[0] = logsig_f(z[0]) * 0.0625f; o[1] = logsig_f(z[1]) * 0.0625f; o[2] = logsig_f(z[2]) * 0.0625f; o[3] = logsig_f(z[3]) * 0.0625f;
                            *(f32x4*)(rowp + bj * HALF + 4 * n) = o; } }
            return;
        }
        const bool tail = (kind == 4) && ((u.pm & 31) == 31), vstat = (u.pn == 7 || u.pn == 8);
#pragma unroll
        for (int ai = 0; ai < 2; ++ai)
#pragma unroll
            for (int m = 0; m < 4; ++m) { const int r = row0 + ai * HALF + m * 16;
                const float rs = rsp[ai * HALF + m * 16];
                bf16_t* rowp = proj + (size_t)r * LDP + u.pn * BM + ct; float s1 = 0.f, s2 = 0.f;
#pragma unroll
                for (int bj = 0; bj < 2; ++bj) { f32x4 v0 = acc[ai][bj][m][0] * rs, v1 = acc[ai][bj][m][1] * rs;
                    if (vstat) { s1 += ((v0[0] + v0[1]) + (v0[2] + v0[3])) + ((v1[0] + v1[1]) + (v1[2] + v1[3]));
                        s2 += ((v0[0] * v0[0] + v0[1] * v0[1]) + (v0[2] * v0[2] + v0[3] * v0[3])) + ((v1[0] * v1[0] + v1[1] * v1[1]) + (v1[2] * v1[2] + v1[3] * v1[3])); }
                    if (tail && ai == 1) { float* dst = (bj ? outv : outk) + (size_t)((u.pm >> 5) * 128 + wr * 64 + m * 16 + fr) * 128 + ct; *(f32x4*)dst = v0; *(f32x4*)(dst + 4) = v1; }
                    if (kind != 0 && kind != 4) {
#pragma unroll
                        for (int i = 0; i < 4; ++i) { v0[i] = in_xform(v0[i], kind); v1[i] = in_xform(v1[i], kind); } }
                    u32x4 w; w.x = cvt_pk_bf16(v0[0], v0[1]); w.y = cvt_pk_bf16(v0[2], v0[3]); w.z = cvt_pk_bf16(v1[0], v1[1]); w.w = cvt_pk_bf16(v1[2], v1[3]);
                    *(u32x4*)(rowp + bj * HALF) = w; }
                if (vstat) { s1 += __shfl_xor(s1, 16); s2 += __shfl_xor(s2, 16); s1 += __shfl_xor(s1, 32); s2 += __shfl_xor(s2, 32);
                    if (fq == 0) { f32x2 o; o[0] = s1; o[1] = s2; *(f32x2*)(vst + (size_t)r * 16 + ((u.pn - 7) * 4 + wc) * 2) = o; } } }
    }
};
struct EpiOut {
    static constexpr bool PERM = true, AFTER_DRAIN = true;
    int l;
    __device__ __forceinline__ void fused(f32x4 (&acc)[2][2][4][2], const Unit& u, int wr, int wc, int fr, int fq, PG8_LAS unsigned char* lds, int wid, int lane) const {
        const kargs_t ka = KA(); unsigned char* const ws = ka->ws;
        float* const xf = ka->out; bf16_t* const xb = (bf16_t*)(ws + WSO_XB); float* const rowss = (float*)(ws + WSO_ROWSS); const bool last = (l == DEPTH - 1);
        PG8_LAS float* P = (PG8_LAS float*)lds;
        const int col0 = u.pn * BM + wc * 32 + 8 * fq;
#pragma unroll
        for (int ai = 0; ai < 2; ++ai) {
            u32x4 xo[4][2];
#pragma unroll
            for (int m = 0; m < 4; ++m)
#pragma unroll
                for (int bj = 0; bj < 2; ++bj) xo[m][bj] = *(const u32x4*)(xb + (size_t)(u.pm * BM + ai * HALF + wr * 64 + m * 16 + fr) * DM + col0 + bj * HALF);
#pragma unroll
            for (int m = 0; m < 4; ++m) { const int rl = ai * HALF + wr * 64 + m * 16 + fr; const size_t off = (size_t)(u.pm * BM + rl) * DM + col0; float ss = 0.f;
#pragma unroll
                for (int bj = 0; bj < 2; ++bj) { const u32x4 o = xo[m][bj]; f32x4 a = acc[ai][bj][m][0], b = acc[ai][bj][m][1];
                    a[0] += __uint_as_float(o.x << 16); a[1] += __uint_as_float(o.x & 0xffff0000u); a[2] += __uint_as_float(o.y << 16); a[3] += __uint_as_float(o.y & 0xffff0000u);
                    b[0] += __uint_as_float(o.z << 16); b[1] += __uint_as_float(o.z & 0xffff0000u); b[2] += __uint_as_float(o.w << 16); b[3] += __uint_as_float(o.w & 0xffff0000u);
                    u32x4 w; w.x = cvt_pk_bf16(a[0], a[1]); w.y = cvt_pk_bf16(a[2], a[3]); w.z = cvt_pk_bf16(b[0], b[1]); w.w = cvt_pk_bf16(b[2], b[3]);
                    *(u32x4*)(xb + off + bj * HALF) = w;
                    if (last) { *(f32x4*)(xf + off + bj * HALF) = a; *(f32x4*)(xf + off + bj * HALF + 4) = b; }
                    ss += ((a[0] * a[0] + a[1] * a[1]) + (a[2] * a[2] + a[3] * a[3])) + ((b[0] * b[0] + b[1] * b[1]) + (b[2] * b[2] + b[3] * b[3])); }
                ss += __shfl_xor(ss, 16); ss += __shfl_xor(ss, 32);
                if (fq == 0) P[rl * 4 + wc] = ss; }
            asm volatile("" ::: "memory"); }
        asm volatile("s_waitcnt lgkmcnt(0)" ::: "memory"); __builtin_amdgcn_s_barrier(); asm volatile("" ::: "memory");
        const int t = wid * 64 + lane;
        if (t < 256) rowss[(size_t)u.pn * MT + u.pm * BM + t] = (P[t * 4 + 0] + P[t * 4 + 1]) + (P[t * 4 + 2] + P[t * 4 + 3]);
    }
};

template <class Epi, class Sched, bool ALIGN_EPI = false, bool SP2 = false>
__device__ __forceinline__ void gemm_phase(PG8_LAS unsigned char* lds, const Gemm g, const Sched& S, const Epi& E) {
    int tid_l = threadIdx.x; asm volatile("" : "+v"(tid_l));
    const int tid = tid_l, wid = __builtin_amdgcn_readfirstlane(tid >> 6), lane = tid & 63, wr = wid >> 2, wc = wid & 3, fr = lane & 15, fq = lane >> 4;
    const int K = g.K, nt = K / BK;
    unsigned voffA[2], voffB[2];
#pragma unroll
    for (int i = 0; i < 2; ++i) { int R, C; stage_rc(tid * 16 + i * 8192, R, C); const int Rb = Epi::PERM ? ((R & ~31) + perm32(R & 31)) : R;
        voffA[i] = (unsigned)(R * K + C) * 2u; voffB[i] = (unsigned)(Rb * K + C) * 2u; }
    const size_t kstep = (size_t)(BK * 2);
    const size_t hstep = (size_t)HALF * K * 2;
    const size_t tstep = 2 * hstep;
    const unsigned ldsw = (unsigned)wid * 1024u;
    const int aoff = lds_byte(wr * 64 + fr, fq * 8), boff = lds_byte(wc * 32 + fr, fq * 8);
#define PG8_SA(b, h) (((b) * 2 + (h)) * HTB)
#define PG8_SB(b, h) ((4 + (b) * 2 + (h)) * HTB)
#define PG8_STAGE(bufoff, gbase, voff) do { _Pragma("unroll") for (int _i = 0; _i < 2; ++_i) \
        __builtin_amdgcn_global_load_lds((const unsigned*)((const char*)(gbase) + (voff)[_i]), (PG8_LAS unsigned*)(lds + (bufoff) + ldsw + _i * 8192), 16, 0, 0); } while (0)
#define PG8_LDA(dst, b, h) do { _Pragma("unroll") for (int m = 0; m < 4; ++m) _Pragma("unroll") for (int k = 0; k < 2; ++k) dst[m][k] = *(const PG8_LAS bf16x8*)(lds + PG8_SA(b, h) + aoff + m * 2048 + k * 1024); } while (0)
#define PG8_LDB(dst, b, h) do { _Pragma("unroll") for (int n = 0; n < 2; ++n) _Pragma("unroll") for (int k = 0; k < 2; ++k) dst[n][k] = *(const PG8_LAS bf16x8*)(lds + PG8_SB(b, h) + boff + n * 2048 + k * 1024); } while (0)
#define PG8_MMA(ai, bj, At, Bt) do { __builtin_amdgcn_s_setprio(1); _Pragma("unroll") for (int m = 0; m < 4; ++m) _Pragma("unroll") for (int n = 0; n < 2; ++n) _Pragma("unroll") for (int k = 0; k < 2; ++k) \
        acc[ai][bj][m][n] = __builtin_amdgcn_mfma_f32_16x16x32_bf16(Bt[n][k], At[m][k], acc[ai][bj][m][n], 0, 0, 0); __builtin_amdgcn_s_setprio(0); } while (0)
#define PG8_WAIT_V(n) asm volatile("s_waitcnt vmcnt(" #n ")" ::: "memory")
#define PG8_WAIT_L(n) asm volatile("s_waitcnt lgkmcnt(" #n ")" ::: "memory")
#define PG8_BAR __builtin_amdgcn_s_barrier()
#define PG8_SCHED __builtin_amdgcn_sched_barrier(0)
    Unit cur, nxt; int ui = 0;
    if (!S.next(0, cur)) return;
    f32x4 acc[2][2][4][2];
#pragma unroll
    for (int a = 0; a < 2; ++a)
#pragma unroll
        for (int b = 0; b < 2; ++b)
#pragma unroll
            for (int m = 0; m < 4; ++m)
#pragma unroll
                for (int n = 0; n < 2; ++n) acc[a][b][m][n] = (f32x4){0.f, 0.f, 0.f, 0.f};
    bf16x8 At[4][2], B0[2][2], B1[2][2];
    const char* cA = (const char*)g.A + (size_t)cur.pm * tstep; const char* cB = (const char*)g.Bt + (size_t)cur.pn * tstep;
    S.a_ready(cur);
    if constexpr (SP2) {
        PG8_STAGE(PG8_SB(0, 0), cB, voffB); PG8_STAGE(PG8_SB(0, 1), cB + hstep, voffB); PG8_STAGE(PG8_SA(0, 0), cA, voffA); PG8_STAGE(PG8_SA(0, 1), cA + hstep, voffA);
        if (wr == 1) PG8_BAR;
        PG8_WAIT_V(2); PG8_BAR;
        PG8_STAGE(PG8_SB(1, 0), cB + kstep, voffB); PG8_STAGE(PG8_SA(1, 0), cA + kstep, voffA); PG8_STAGE(PG8_SB(1, 1), cB + hstep + kstep, voffB);
        PG8_WAIT_V(6); PG8_BAR;
    } else {
        PG8_STAGE(PG8_SB(0, 0), cB, voffB); PG8_STAGE(PG8_SA(0, 0), cA, voffA); PG8_STAGE(PG8_SB(0, 1), cB + hstep, voffB); PG8_STAGE(PG8_SA(0, 1), cA + hstep, voffA);
        if (wr == 1) PG8_BAR;
        PG8_WAIT_V(4); PG8_BAR;
        PG8_STAGE(PG8_SB(1, 0), cB + kstep, voffB); PG8_STAGE(PG8_SA(1, 0), cA + kstep, voffA); PG8_STAGE(PG8_SB(1, 1), cB + hstep + kstep, voffB);
        PG8_WAIT_V(6); PG8_BAR;
    }
    for (;;) {
        const bool has_next = S.next(ui + 1, nxt);
        const char* nA = has_next ? (const char*)g.A + (size_t)nxt.pm * tstep : cA; const char* nB = has_next ? (const char*)g.Bt + (size_t)nxt.pn * tstep : cB;
        for (int t = 0; t < nt; t += 2) {
            const bool last = (t == nt - 2);
            const char* a1 = cA + (size_t)(t + 1) * kstep;
            const char* a2 = last ? nA : cA + (size_t)(t + 2) * kstep; const char* b2 = last ? nB : cB + (size_t)(t + 2) * kstep;
            const char* a3 = a2 + kstep; const char* b3 = b2 + kstep;
            if (last && has_next) S.a_ready(nxt);
            if constexpr (SP2) {
            PG8_LDB(B0, 0, 0); PG8_LDB(B1, 0, 1); PG8_SCHED; PG8_LDA(At, 0, 0); PG8_STAGE(PG8_SA(1, 1), a1 + hstep, voffA);
            PG8_WAIT_V(8); PG8_WAIT_L(0); PG8_BAR; PG8_MMA(0, 0, At, B0); PG8_MMA(0, 1, At, B1); PG8_BAR; PG8_SCHED;
            PG8_LDA(At, 0, 1); PG8_STAGE(PG8_SB(0, 0), b2, voffB); PG8_STAGE(PG8_SB(0, 1), b2 + hstep, voffB); PG8_STAGE(PG8_SA(0, 0), a2, voffA);
            PG8_WAIT_V(8); PG8_WAIT_L(0); PG8_BAR; PG8_MMA(1, 0, At, B0); PG8_MMA(1, 1, At, B1); PG8_BAR; PG8_SCHED;
            PG8_LDB(B0, 1, 0); PG8_LDB(B1, 1, 1); PG8_SCHED; PG8_LDA(At, 1, 0); PG8_STAGE(PG8_SA(0, 1), a2 + hstep, voffA);
            PG8_WAIT_V(8); PG8_WAIT_L(0); PG8_BAR; PG8_MMA(0, 0, At, B0); PG8_MMA(0, 1, At, B1); PG8_BAR; PG8_SCHED;
            PG8_LDA(At, 1, 1); PG8_STAGE(PG8_SB(1, 0), b3, voffB); PG8_STAGE(PG8_SB(1, 1), b3 + hstep, voffB); PG8_STAGE(PG8_SA(1, 0), a3, voffA);
            PG8_WAIT_V(8); PG8_WAIT_L(0); PG8_BAR; PG8_MMA(1, 0, At, B0); PG8_MMA(1, 1, At, B1); PG8_BAR; PG8_SCHED;
            } else {
            PG8_LDB(B0, 0, 0); PG8_SCHED; PG8_LDA(At, 0, 0); PG8_STAGE(PG8_SA(1, 1), a1 + hstep, voffA);
            PG8_WAIT_L(8); PG8_BAR; PG8_WAIT_L(0); PG8_MMA(0, 0, At, B0); PG8_BAR; PG8_SCHED;
            PG8_LDB(B1, 0, 1); PG8_STAGE(PG8_SB(0, 0), b2, voffB);
            PG8_BAR; PG8_WAIT_L(0); PG8_MMA(0, 1, At, B1); PG8_BAR;
            PG8_LDA(At, 0, 1); PG8_STAGE(PG8_SA(0, 0), a2, voffA);
            PG8_BAR; PG8_WAIT_L(0); PG8_MMA(1, 0, At, B0); PG8_BAR; PG8_SCHED;
            PG8_STAGE(PG8_SB(0, 1), b2 + hstep, voffB);
            PG8_WAIT_V(6); PG8_BAR; PG8_MMA(1, 1, At, B1); PG8_BAR;
            PG8_LDB(B0, 1, 0); PG8_SCHED; PG8_LDA(At, 1, 0); PG8_STAGE(PG8_SA(0, 1), a2 + hstep, voffA);
            PG8_WAIT_L(8); PG8_BAR; PG8_WAIT_L(0); PG8_MMA(0, 0, At, B0); PG8_BAR; PG8_SCHED;
            PG8_LDB(B1, 1, 1); PG8_STAGE(PG8_SB(1, 0), b3, voffB);
            PG8_BAR; PG8_WAIT_L(0); PG8_MMA(0, 1, At, B1); PG8_BAR;
            PG8_LDA(At, 1, 1); PG8_STAGE(PG8_SA(1, 0), a3, voffA);
            PG8_BAR; PG8_WAIT_L(0); PG8_MMA(1, 0, At, B0); PG8_BAR; PG8_SCHED;
            PG8_STAGE(PG8_SB(1, 1), b3 + hstep, voffB);
            PG8_WAIT_V(6); PG8_BAR; PG8_MMA(1, 1, At, B1); PG8_BAR;
            }
        }
        if constexpr (ALIGN_EPI) { if (wr == 0) PG8_BAR; }
        if constexpr (!Epi::AFTER_DRAIN) { E(acc, cur, wr, wc, fr, fq); S.done(cur); }
        if (!has_next) break;
#pragma unroll
        for (int a = 0; a < 2; ++a)
#pragma unroll
            for (int b = 0; b < 2; ++b)
#pragma unroll
                for (int m = 0; m < 4; ++m)
#pragma unroll
                    for (int n = 0; n < 2; ++n) acc[a][b][m][n] = (f32x4){0.f, 0.f, 0.f, 0.f};
        cur = nxt; cA = nA; cB = nB; ++ui;
        if constexpr (ALIGN_EPI) { if (wr == 1) PG8_BAR; }
    }
    PG8_WAIT_V(0);
    if constexpr (!ALIGN_EPI) { if (wr == 0) PG8_BAR; }
    PG8_BAR;
    if constexpr (Epi::AFTER_DRAIN) { E.fused(acc, cur, wr, wc, fr, fq, lds, wid, lane); S.done(cur); }
#undef PG8_SA
#undef PG8_SB
#undef PG8_STAGE
#undef PG8_LDA
#undef PG8_LDB
#undef PG8_MMA
#undef PG8_WAIT_V
#undef PG8_WAIT_L
#undef PG8_BAR
#undef PG8_SCHED
}
}
#define GAS __attribute__((address_space(1)))
#define LAS __attribute__((address_space(3)))
typedef unsigned short bf16;
typedef unsigned v4u __attribute__((ext_vector_type(4)));
typedef float f32x4 __attribute__((ext_vector_type(4)));
typedef short bf16x8 __attribute__((ext_vector_type(8)));
typedef GAS unsigned gu32;
typedef GAS unsigned long long gu64;
#define RLX_AGENT __ATOMIC_RELAXED, __HIP_MEMORY_SCOPE_AGENT
#define LDS_WAIT() asm volatile("s_waitcnt lgkmcnt(0)" ::: "memory")
#define VM_WAIT() asm volatile("s_waitcnt vmcnt(0)" ::: "memory")
__device__ __forceinline__ unsigned long long rt() { return __builtin_amdgcn_s_memrealtime(); }
__device__ __forceinline__ unsigned f2bf(float f) { unsigned u = __builtin_bit_cast(unsigned, f); return (u + 0x7fffu + ((u >> 16) & 1u)) >> 16; }
__device__ __forceinline__ unsigned pk2(float lo, float hi) { return f2bf(lo) | (f2bf(hi) << 16); }

#define XB_TMO      128
#define XB_XCNT(j)  (256  + 64 * (j))
#define XB_XSUB(j)  (1280 + 64 * (j))
#define XB_XGEN(j)  (2304 + 64 * (j))
#define XB_TOP      3328
#define XB_TOPGEN   3392
#define XCD_BAR_WORDS 3456
#define XB_SPIN_CAP (1u << 18)

__device__ __forceinline__ unsigned xb_ld(unsigned* p)              { return __hip_atomic_load(p, __ATOMIC_RELAXED, __HIP_MEMORY_SCOPE_AGENT); }
__device__ __forceinline__ unsigned xb_add(unsigned* p, unsigned v) { return __hip_atomic_fetch_add(p, v, __ATOMIC_RELAXED, __HIP_MEMORY_SCOPE_AGENT); }
__device__ __forceinline__ unsigned xb_xcc_id() { return (unsigned)__builtin_amdgcn_s_getreg((3 << 11) | 20) & 0xFu; }
#define XB_SPIN(cond, bar) do { unsigned _sp = 0; while (cond) { __builtin_amdgcn_s_sleep(1); \
    if ((++_sp & 255u) == 0u) { if (xb_ld(&(bar)[XB_TMO])) break; if (_sp > XB_SPIN_CAP) { atomicAdd(&(bar)[XB_TMO], 1u); break; } } } } while (0)

struct XcdBarrier {
    unsigned* bar; unsigned x;
    volatile LAS unsigned* st;
};

__device__ __forceinline__ XcdBarrier xcd_barrier_post(unsigned* bar, volatile LAS unsigned* st) {
    XcdBarrier b; b.bar = bar; b.x = xb_xcc_id(); b.st = st;
    if (threadIdx.x == 0) (void)xb_add(&bar[XB_XCNT(b.x)], 1u);
    return b;
}
__device__ __forceinline__ void xcd_barrier_complete(unsigned* bar, unsigned x, unsigned& nloc, unsigned& nx) {
    const unsigned G = gridDim.x * gridDim.y * gridDim.z;
    unsigned sum, cnt, mine, sp = 0u;
    for (;;) {
        sum = 0u; cnt = 0u; mine = 0u;
#pragma unroll
        for (unsigned j = 0; j < 16; ++j) { const unsigned c = xb_ld(&bar[XB_XCNT(j)]); sum += c; cnt += (c > 0u) ? 1u : 0u; mine = (j == x) ? c : mine; }
        if (sum == G) break;
        __builtin_amdgcn_s_sleep(1);
        if ((++sp & 255u) == 0u) { if (xb_ld(&bar[XB_TMO])) break; if (sp > XB_SPIN_CAP) { atomicAdd(&bar[XB_TMO], 1u); break; } }
    }
    nloc = mine > 0u ? mine : 1u; nx = cnt > 0u ? cnt : 1u;
}

__device__ __forceinline__ void xcd_barrier(const XcdBarrier& b) {
    asm volatile("s_waitcnt vmcnt(0)" ::: "memory");
    __syncthreads();
    if (threadIdx.x == 0) {
        unsigned* bar = b.bar;
        __builtin_amdgcn_s_waitcnt(0);
        unsigned nloc = b.st[0], nx = b.st[1];
        if (nloc == 0u) { xcd_barrier_complete(bar, b.x, nloc, nx); b.st[0] = nloc; b.st[1] = nx; }
        const unsigned old = xb_add(&bar[XB_XSUB(b.x)], 1u);
        const unsigned gen = old / nloc;
        if (old + 1u == (gen + 1u) * nloc) {
            __builtin_amdgcn_fence(__ATOMIC_RELEASE, "agent");
            asm volatile("s_waitcnt vmcnt(0)" ::: "memory");
            const unsigned og = xb_add(&bar[XB_TOP], 1u);
            const unsigned tg = og / nx;
            if (og + 1u == (tg + 1u) * nx) xb_add(&bar[XB_TOPGEN], 1u);
            else XB_SPIN(xb_ld(&bar[XB_TOPGEN]) == tg, bar);
            __builtin_amdgcn_fence(__ATOMIC_ACQUIRE, "agent");
            xb_add(&bar[XB_XGEN(b.x)], 1u);
            asm volatile("s_waitcnt vmcnt(0)" ::: "memory");
        } else {
            XB_SPIN(xb_ld(&bar[XB_XGEN(b.x)]) == gen, bar);
            __builtin_amdgcn_fence(__ATOMIC_ACQUIRE, "agent");
            asm volatile("s_waitcnt vmcnt(0)" ::: "memory");
        }
    }
    __syncthreads();
}
#define DI __device__ __forceinline__
typedef float f32x16 __attribute__((ext_vector_type(16)));
typedef short s16x4 __attribute__((ext_vector_type(4)));
typedef short v4i16_t __attribute__((ext_vector_type(4)));
typedef unsigned u32x2 __attribute__((ext_vector_type(2)));
typedef float f32x2_t __attribute__((ext_vector_type(2)));
typedef __bf16 bf16x2_t __attribute__((ext_vector_type(2)));
typedef LAS unsigned char* ldsp;
typedef const LAS unsigned char* cldsp;
DI unsigned cvtpk(float lo, float hi) { f32x2_t v = {lo, hi}; bf16x2_t b = __builtin_convertvector(v, bf16x2_t); return __builtin_bit_cast(unsigned, b); }
DI unsigned short f2b(float x) { return (unsigned short)(cvtpk(x, 0.f) & 0xffffu); }
DI float b2f(unsigned short h) { return __uint_as_float((unsigned)h << 16); }
DI float blo(unsigned w) { return __uint_as_float(w << 16); }
DI float bhi(unsigned w) { return __uint_as_float(w & 0xffff0000u); }
DI int crow(int reg, int h) { return (reg & 3) + 8 * (reg >> 2) + 4 * h; }
#define MFMA32(a, b, c) __builtin_amdgcn_mfma_f32_32x32x16_bf16((a), (b), (c), 0, 0, 0)
#define MFMA16(a, b, c) __builtin_amdgcn_mfma_f32_16x16x32_bf16((a), (b), (c), 0, 0, 0)
DI s16x4 tr4(cldsp p) { return __builtin_bit_cast(s16x4, __builtin_amdgcn_ds_read_tr16_b64_v4i16((LAS v4i16_t*)p)); }
DI bf16x8 trfrag(cldsp base, int stride, int k0a, int k0b, int n0, int lane) {
    const int q = (lane & 15) >> 2, p = lane & 3, blk = (lane >> 4) & 1;
    const int off = 2 * (n0 + 16 * blk) + 8 * p;
    const s16x4 lo = tr4(base + (k0a + q) * stride + off), hi = tr4(base + (k0b + q) * stride + off);
    return (bf16x8){lo[0], lo[1], lo[2], lo[3], hi[0], hi[1], hi[2], hi[3]};
}
DI bf16x8 pack8(const f32x16& x, int s) {
    v4u p; p.x = cvtpk(x[8 * s], x[8 * s + 1]); p.y = cvtpk(x[8 * s + 2], x[8 * s + 3]); p.z = cvtpk(x[8 * s + 4], x[8 * s + 5]); p.w = cvtpk(x[8 * s + 6], x[8 * s + 7]);
    return __builtin_bit_cast(bf16x8, p);
}
DI bf16x8 lds16(cldsp p) { return *(const LAS bf16x8*)p; }
#define WG_SYNC() __syncthreads()

__constant__ unsigned char T5_BUCKET[128] = {0, 1, 2, 3, 4, 5, 6, 7, 8, 9, 10, 11, 12, 13, 14, 15, 16, 16, 16, 17, 17, 18, 18, 18, 19, 19, 19, 20, 20, 20, 20, 21, 21, 21, 21, 22, 22, 22, 22, 22, 23, 23, 23, 23, 23, 23, 24, 24, 24, 24, 24, 24, 25, 25, 25, 25, 25, 25, 25, 26, 26, 26, 26, 26, 26, 26, 26, 27, 27, 27, 27, 27, 27, 27, 27, 27, 27, 28, 28, 28, 28, 28, 28, 28, 28, 28, 28, 29, 29, 29, 29, 29, 29, 29, 29, 29, 29, 29, 29, 30, 30, 30, 30, 30, 30, 30, 30, 30, 30, 30, 30, 30, 30, 31, 31, 31, 31, 31, 31, 31, 31, 31, 31, 31, 31, 31, 31, 31};

DI void conv_tile(const float* W, int ldw, int K, bf16* WT, int k0, int n0, int nrow0, const float* gk, LAS float* scr, int lane) {
#pragma unroll 8
    for (int i = 0; i < 32; ++i) { const int kk = 2 * i + (lane >> 5); float v = W[(size_t)(k0 + kk) * ldw + n0 + (lane & 31)]; if (gk) v *= gk[k0 + kk]; scr[kk * 33 + (lane & 31)] = v; }
    LDS_WAIT(); asm volatile("" ::: "memory");
    const int c = lane & 7;
#pragma unroll
    for (int j = 0; j < 4; ++j) { const int n = (lane >> 3) + 8 * j; const LAS float* s = scr + (8 * c) * 33 + n;
        v4u o; o.x = cvtpk(s[0 * 33], s[1 * 33]); o.y = cvtpk(s[2 * 33], s[3 * 33]); o.z = cvtpk(s[4 * 33], s[5 * 33]); o.w = cvtpk(s[6 * 33], s[7 * 33]);
        *(v4u*)(WT + (size_t)(nrow0 + n) * K + k0 + 8 * c) = o; }
    LDS_WAIT(); asm volatile("" ::: "memory");
}
DI void conv_tile_eff(const float* Wl, const float* wup, const float* gk, bf16* WT, int k0, int j0, LAS float* scr, int lane) {
    const int j = j0 + (lane & 31);
    float wu[16];
#pragma unroll
    for (int r = 0; r < 16; ++r) wu[r] = wup[r * 256 + j];
#pragma unroll 4
    for (int i = 0; i < 32; ++i) { const int kk = 2 * i + (lane >> 5); const float* wr = Wl + (size_t)(k0 + kk) * DIN_RAW + 4352; float s = 0.f;
#pragma unroll
        for (int r = 0; r < 16; ++r) s += wr[r] * wu[r];
        scr[kk * 33 + (lane & 31)] = s * gk[k0 + kk]; }
    LDS_WAIT(); asm volatile("" ::: "memory");
    const int c = lane & 7;
#pragma unroll
    for (int jj = 0; jj < 4; ++jj) { const int n = (lane >> 3) + 8 * jj; const LAS float* s = scr + (8 * c) * 33 + n;
        v4u o; o.x = cvtpk(s[0 * 33], s[1 * 33]); o.y = cvtpk(s[2 * 33], s[3 * 33]); o.z = cvtpk(s[4 * 33], s[5 * 33]); o.w = cvtpk(s[6 * 33], s[7 * 33]);
        *(v4u*)(WT + (size_t)(4352 + j0 + n) * DM + k0 + 8 * c) = o; }
    LDS_WAIT(); asm volatile("" ::: "memory");
}
constexpr int CONV_IN_WT = 16 * 136 + 16 * 8, CONV_IN_ITEMS = CONV_IN_WT / 8;
constexpr int CONV_OUT_WT = 24 * 32, CONV_OUT_ITEMS = CONV_OUT_WT / 8;
DI void conv_in_item(int it, const float* Wl, const float* wup, const float* gk, bf16* WT, ldsp lds, int wave, int lane) {
    LAS float* scr = (LAS float*)(lds + wave * 16384);
    const int wt = it * 8 + wave;
    if (wt < 16 * 136) conv_tile(Wl, DIN_RAW, DM, WT, 64 * (wt / 136), 32 * (wt % 136), 32 * (wt % 136), gk, scr, lane);
    else { const int e = wt - 16 * 136; conv_tile_eff(Wl, wup, gk, WT, 64 * (e >> 3), 32 * (e & 7), scr, lane); }
}
DI void conv_out_item(int it, const float* Wl, bf16* WT, ldsp lds, int wave, int lane) {
    LAS float* scr = (LAS float*)(lds + wave * 16384);
    const int wt = it * 8 + wave;
    conv_tile(Wl, DM, DMIX, WT, 64 * (wt >> 5), 32 * (wt & 31), 32 * (wt & 31), nullptr, scr, lane);
}
DI void row_to_bf16(const float* xrow, bf16* orow, float* ss0, float* ss1, float* ss2, float* ss3, int lane) {
    const f32x4* xr = (const f32x4*)xrow + lane; f32x4 v[4]; float s = 0.f;
#pragma unroll
    for (int j = 0; j < 4; ++j) { v[j] = xr[64 * j]; s += (v[j][0] * v[j][0] + v[j][1] * v[j][1]) + (v[j][2] * v[j][2] + v[j][3] * v[j][3]); }
#pragma unroll
    for (int o = 1; o < 64; o <<= 1) s += __shfl_xor(s, o);
    u32x2* o8 = (u32x2*)orow + lane;
#pragma unroll
    for (int j = 0; j < 4; ++j) { u32x2 w; w.x = cvtpk(v[j][0], v[j][1]); w.y = cvtpk(v[j][2], v[j][3]); o8[64 * j] = w; }
    if (lane == 0 && ss0) { *ss0 = s; *ss1 = 0.f; *ss2 = 0.f; *ss3 = 0.f; }
}
DI void final_row(float* xrow, const float* g, int lane) {
    f32x4* xr = (f32x4*)xrow + lane; const f32x4* gr = (const f32x4*)g + lane; f32x4 v[4]; float s = 0.f;
#pragma unroll
    for (int j = 0; j < 4; ++j) { v[j] = xr[64 * j]; s += (v[j][0] * v[j][0] + v[j][1] * v[j][1]) + (v[j][2] * v[j][2] + v[j][3] * v[j][3]); }
#pragma unroll
    for (int o = 1; o < 64; o <<= 1) s += __shfl_xor(s, o);
    const float rs = 1.0f / sqrtf(s * (1.0f / DM) + EPS);
#pragma unroll
    for (int j = 0; j < 4; ++j) xr[64 * j] = v[j] * rs * gr[64 * j];
}

template <int NT, bool SSQ> DI void sgemm(const bf16* A, int lda, const bf16* Bt, int K, int n0, f32x4 (&acc)[NT], float& ssq, int wave, int lane) {
    const int fr = lane & 15, fq = lane >> 4;
    const bf16* ap = A + (size_t)(16 * wave + fr) * lda + 8 * fq;
    const bf16* bp = Bt + (size_t)(n0 + fr) * K + 8 * fq;
#pragma unroll
    for (int t = 0; t < NT; ++t) acc[t] = (f32x4){0.f, 0.f, 0.f, 0.f};
    float s = 0.f;
#pragma unroll 4
    for (int k = 0; k < K; k += 32) {
        const bf16x8 a = *(const bf16x8*)(ap + k);
#pragma unroll
        for (int t = 0; t < NT; ++t) { const bf16x8 b = *(const bf16x8*)(bp + (size_t)t * 16 * K + k); acc[t] = MFMA16(b, a, acc[t]); }
        if (SSQ) {
#pragma unroll
            for (int j = 0; j < 8; ++j) { const float f = b2f((unsigned short)a[j]); s += f * f; } }
    }
    if (SSQ) { s += __shfl_xor(s, 16); s += __shfl_xor(s, 32); }
    ssq = s;
}
constexpr int SIN_ITEMS = NIN / 32, SOUT_ITEMS = DM / 16;
DI void sin_item(int it, const bf16* XB, const bf16* WinT, bf16* PROJ, float* LA, const float* bup, int wave, int lane) {
    f32x4 acc[2]; float ssq; const int n0 = it * 32;
    sgemm<2, true>(XB + (size_t)MP * DM, DM, WinT, DM, n0, acc, ssq, wave, lane);
    const int fr = lane & 15, fq = lane >> 4, row = MP + 16 * wave + fr, kind = in_kind(n0 >> 8);
    const float rs = 1.0f / sqrtf(ssq * (1.0f / DM) + EPS);
#pragma unroll
    for (int t = 0; t < 2; ++t) { const int col = n0 + 16 * t + 4 * fq; f32x4 v = acc[t] * rs;
        if (kind == 5) { const f32x4 bv = *(const f32x4*)(bup + col - 4352); f32x4 o;
#pragma unroll
            for (int i = 0; i < 4; ++i) o[i] = logsig_f(v[i] + bv[i]) * 0.0625f;
            *(f32x4*)(LA + (size_t)row * 256 + col - 4352) = o; }
        else {
#pragma unroll
            for (int i = 0; i < 4; ++i) v[i] = in_xform(v[i], kind);
            u32x2 w; w.x = cvtpk(v[0], v[1]); w.y = cvtpk(v[2], v[3]); *(u32x2*)(PROJ + (size_t)row * LDP + col) = w; } }
}
DI void sout_item(int it, const bf16* Y, const bf16* WoutT, float* xf  , bf16* XB, bool last, int wave, int lane) {
    f32x4 acc[1]; float ssq; const int n0 = it * 16;
    sgemm<1, false>(Y + (size_t)MP * DMIX, DMIX, WoutT, DMIX, n0, acc, ssq, wave, lane);
    const int fr = lane & 15, fq = lane >> 4, rs = 16 * wave + fr, col = n0 + 4 * fq;
    bf16* xp = XB + (size_t)(MP + rs) * DM + col; const u32x2 o = *(const u32x2*)xp;
    const f32x4 xn = {acc[0][0] + blo(o.x), acc[0][1] + bhi(o.x), acc[0][2] + blo(o.y), acc[0][3] + bhi(o.y)};
    u32x2 w; w.x = cvtpk(xn[0], xn[1]); w.y = cvtpk(xn[2], xn[3]); *(u32x2*)xp = w;
    if (last) *(f32x4*)(xf + (size_t)rs * DM + col) = xn;
}

constexpr int GLA_ITEMS = 2 * 128 * 4, KSTR = 144, VSTR = 272;
DI void gla_cumsum(const float* LA, int row0, int h, LAS float* SEG, int tid, float (&a)[8], float& off, float& bl) {
    const int d = tid & 63, seg = tid >> 6;
#pragma unroll
    for (int i = 0; i < 8; ++i) a[i] = LA[(size_t)(row0 + seg * 8 + i) * 256 + h * 64 + d];
#pragma unroll
    for (int i = 1; i < 8; ++i) a[i] += a[i - 1];
    SEG[seg * 64 + d] = a[7];
    WG_SYNC();
    off = 0.f; bl = 0.f;
#pragma unroll
    for (int s = 0; s < 8; ++s) { const float v = SEG[s * 64 + d]; bl += v; if (s < seg) off += v; }
}
DI void gla1_item(int it, const bf16* PROJ, const float* LA, float* DS, float* AG, ldsp lds, int tid, int wave, int lane) {
    const int h = it & 3, row0 = (it >> 2) * 64, d = tid & 63, seg = tid >> 6;
    LAS float* SEG = (LAS float*)lds; ldsp KD = lds + 2048, V = lds + 2048 + 64 * KSTR;
#pragma unroll
    for (int i = 0; i < 2; ++i) { const int c = tid + 512 * i, r = c >> 4, p = c & 15;
        *(LAS v4u*)(V + r * VSTR + p * 16) = *(const v4u*)(PROJ + (size_t)(row0 + r) * LDP + C_VC + h * 128 + p * 8); }
    float a[8], off, bl; gla_cumsum(LA, row0, h, SEG, tid, a, off, bl);
#pragma unroll
    for (int i = 0; i < 8; ++i) { const int t = seg * 8 + i; const float b = a[i] + off;
        const float k = b2f(PROJ[(size_t)(row0 + t) * LDP + C_KC + h * 64 + d]);
        *(LAS unsigned short*)(KD + t * KSTR + d * 2) = f2b(k * __expf(bl - b)); }
    if (seg == 0) AG[(size_t)it * 64 + d] = __expf(bl);
    WG_SYNC();
    const int dt = wave & 1, vt = wave >> 1, hh = lane >> 5;
    f32x16 acc = {};
#pragma unroll
    for (int ks = 0; ks < 4; ++ks) { const int k0 = 16 * ks + 8 * hh;
        const bf16x8 A = trfrag(KD, KSTR, k0, k0 + 4, 32 * dt, lane), B = trfrag(V, VSTR, k0, k0 + 4, 32 * vt, lane);
        acc = MFMA32(A, B, acc); }
    float* dst = DS + (size_t)it * 8192 + 32 * vt + (lane & 31);
#pragma unroll
    for (int r = 0; r < 16; ++r) dst[(32 * dt + crow(r, hh)) * 128] = acc[r];
    WG_SYNC();
}
constexpr int SCAN_ITEMS = 2 * 4 * 32;
DI void scan_item(int it, float* DS, float* DSW  , const float* AG, float* gout  , ldsp lds, int tid) {
    const int bh = it >> 5, part = it & 31, b = bh >> 2, h = bh & 3, e = part * 256 + (tid & 255), dl = (tid & 255) >> 7;
    LAS float* AGL = (LAS float*)lds;
    if (tid < 256) { const int n = tid >> 1, dd = tid & 1; AGL[tid] = AG[(size_t)((b * 128 + n) * 4 + h) * 64 + 2 * part + dd]; }
    WG_SYNC();
    if (tid < 256) {
        float S = 0.f;
        float* p = DS + (size_t)(b * 128 * 4 + h) * 8192 + e; float* pw = DSW + (size_t)(b * 128 * 4 + h) * 8192 + e;
#pragma unroll 1
        for (int half = 0; half < 2; ++half) {
            float ds[64];
#pragma unroll
            for (int j = 0; j < 64; ++j) ds[j] = p[(size_t)(half * 64 + j) * 4 * 8192];
#pragma unroll
            for (int j = 0; j < 64; ++j) { pw[(size_t)(half * 64 + j) * 4 * 8192] = S; S = AGL[(half * 64 + j) * 2 + dl] * S + ds[j]; }
        }
        gout[(size_t)(b * 4 + h) * 8192 + e] = S;
    }
    WG_SYNC();
}
DI void gla2_item(int it, const bf16* PROJ, const float* LA, const float* DS, const float* gn, bf16* Y, ldsp lds, int tid, int wave, int lane) {
    const int h = it & 3, row0 = (it >> 2) * 64, d = tid & 63, seg = tid >> 6;
    LAS float* SEG = (LAS float*)lds; ldsp QD = lds + 2048, KI = QD + 64 * KSTR, V = KI + 64 * KSTR, SP = V + 64 * VSTR; LAS float* SS = (LAS float*)(SP + 64 * VSTR);
#pragma unroll
    for (int i = 0; i < 2; ++i) { const int c = tid + 512 * i, r = c >> 4, p = c & 15;
        *(LAS v4u*)(V + r * VSTR + p * 16) = *(const v4u*)(PROJ + (size_t)(row0 + r) * LDP + C_VC + h * 128 + p * 8); }
#pragma unroll
    for (int i = 0; i < 4; ++i) { const int c = tid + 512 * i, r = c >> 5, p = c & 31; const f32x4 s = *(const f32x4*)(DS + (size_t)it * 8192 + r * 128 + p * 4);
        u32x2 w; w.x = cvtpk(s[0], s[1]); w.y = cvtpk(s[2], s[3]); *(LAS u32x2*)(SP + r * VSTR + p * 8) = w; }
    float a[8], off, bl; gla_cumsum(LA, row0, h, SEG, tid, a, off, bl);
#pragma unroll
    for (int i = 0; i < 8; ++i) { const int t = seg * 8 + i; const float b = a[i] + off;
        const float q = b2f(PROJ[(size_t)(row0 + t) * LDP + C_QC + h * 64 + d]), k = b2f(PROJ[(size_t)(row0 + t) * LDP + C_KC + h * 64 + d]);
        *(LAS unsigned short*)(QD + t * KSTR + d * 2) = f2b(q * __expf(b));
        *(LAS unsigned short*)(KI + t * KSTR + d * 2) = f2b(k * __expf(-b)); }
    WG_SYNC();
    const int qi = wave & 1, vt = wave >> 1, hh = lane >> 5, r = lane & 31;
    bf16x8 Qf[4];
#pragma unroll
    for (int ks = 0; ks < 4; ++ks) Qf[ks] = lds16(QD + (32 * qi + r) * KSTR + (16 * ks + 8 * hh) * 2);
    f32x16 acc = {};
#pragma unroll
    for (int ks = 0; ks < 4; ++ks) { const int k0 = 16 * ks + 8 * hh; acc = MFMA32(trfrag(SP, VSTR, k0, k0 + 4, 32 * vt, lane), Qf[ks], acc); }
    for (int si = 0; si <= qi; ++si) {
        f32x16 X = {};
#pragma unroll
        for (int ks = 0; ks < 4; ++ks) X = MFMA32(lds16(KI + (32 * si + r) * KSTR + (16 * ks + 8 * hh) * 2), Qf[ks], X);
        if (si == qi) {
#pragma unroll
            for (int g = 0; g < 16; ++g) if (crow(g, hh) > r) X[g] = 0.f; }
#pragma unroll
        for (int s2 = 0; s2 < 2; ++s2) { const int k0 = 32 * si + 16 * s2 + 4 * hh;
            acc = MFMA32(trfrag(V, VSTR, k0, k0 + 8, 32 * vt, lane), pack8(X, s2), acc); }
    }
    float ss = 0.f;
#pragma unroll
    for (int g = 0; g < 16; ++g) ss += acc[g] * acc[g];
    ss += __shfl_xor(ss, 32);
    if (hh == 0) SS[wave * 32 + r] = ss;
    WG_SYNC();
    const float tot = (SS[qi * 32 + r] + SS[(qi + 2) * 32 + r]) + (SS[(qi + 4) * 32 + r] + SS[(qi + 6) * 32 + r]);
    const float rs = 1.0f / sqrtf(tot * (1.0f / 128.0f) + EPS);
    const size_t row = (size_t)(row0 + 32 * qi + r);
#pragma unroll
    for (int g = 0; g < 4; ++g) { const int dv0 = h * 128 + 32 * vt + 8 * g + 4 * hh;
        const u32x2 gt = *(const u32x2*)(PROJ + row * LDP + C_GC + dv0); const f32x4 gw = *(const f32x4*)(gn + dv0);
        u32x2 w; w.x = cvtpk(acc[4 * g] * rs * gw[0] * blo(gt.x), acc[4 * g + 1] * rs * gw[1] * bhi(gt.x)); w.y = cvtpk(acc[4 * g + 2] * rs * gw[2] * blo(gt.y), acc[4 * g + 3] * rs * gw[3] * bhi(gt.y));
        *(u32x2*)(Y + row * DMIX + 1024 + dv0) = w; }
    WG_SYNC();
}

constexpr int SWA_ITEMS = 2 * 64 * 2;
constexpr float NEGL = -1e30f;
DI void swa_item(int it, const bf16* PROJ, const float* rel_bias, const float* sink, bf16* Y, ldsp lds, int tid, int wave, int lane) {
    const int kv = it & 1, bq = it >> 1, qb = bq & 63, tok0 = bq * 128;
    ldsp K = lds, V = lds + 256 * KSTR; LAS float* BT = (LAS float*)(V + 256 * KSTR);
#pragma unroll
    for (int i = 0; i < 4; ++i) { const int c = tid + 512 * i, j = c >> 3, p = c & 7; v4u kk = {0u, 0u, 0u, 0u}, vv = {0u, 0u, 0u, 0u};
        if (qb > 0 || j >= 128) { const bf16* src = PROJ + (size_t)(tok0 - 128 + j) * LDP + kv * 64 + p * 8; kk = *(const v4u*)(src + C_KA); vv = *(const v4u*)(src + C_VA); }
        *(LAS v4u*)(K + j * KSTR + p * 16) = kk; *(LAS v4u*)(V + j * KSTR + p * 16) = vv; }
    { const int g = tid >> 7, dist = tid & 127; BT[tid] = rel_bias[T5_BUCKET[dist] * 8 + kv * 4 + g] * LOG2E; }
    WG_SYNC();
    const int g = wave >> 1, head = kv * 4 + g, hh = lane >> 5, r = lane & 31;
    const float snk = sink[head] * LOG2E;
    for (int qq = 0; qq < 2; ++qq) {
        const int qg = 2 * (wave & 1) + qq; const size_t qrow = (size_t)(tok0 + 32 * qg + r);
        bf16x8 Qf[4];
#pragma unroll
        for (int ks = 0; ks < 4; ++ks) Qf[ks] = *(const bf16x8*)(PROJ + qrow * LDP + C_QA + head * 64 + 16 * ks + 8 * hh);
        f32x16 S[5];
#pragma unroll
        for (int t = 0; t < 5; ++t) { S[t] = (f32x16){};
#pragma unroll
            for (int ks = 0; ks < 4; ++ks) S[t] = MFMA32(lds16(K + (32 * (qg + t) + r) * KSTR + (16 * ks + 8 * hh) * 2), Qf[ks], S[t]); }
        float mx = snk;
#pragma unroll
        for (int t = 0; t < 5; ++t)
#pragma unroll
            for (int x = 0; x < 16; ++x) { const int cr = crow(x, hh), j = 32 * (qg + t) + cr, dist = 128 + r - 32 * t - cr;
                bool ok = (qb > 0 || j >= 128); if (t == 0) ok = ok && (cr > r); if (t == 4) ok = ok && (cr <= r);
                const float lg = ok ? S[t][x] + BT[g * 128 + (dist & 127)] : NEGL; S[t][x] = lg; mx = fmaxf(mx, lg); }
        mx = fmaxf(mx, __shfl_xor(mx, 32));
        float l = 0.f;
#pragma unroll
        for (int t = 0; t < 5; ++t)
#pragma unroll
            for (int x = 0; x < 16; ++x) { const float p = __builtin_amdgcn_exp2f(S[t][x] - mx); S[t][x] = p; l += p; }
        l += __shfl_xor(l, 32); l += __builtin_amdgcn_exp2f(snk - mx);
        const float inv = 1.0f / l;
        f32x16 O[2] = {(f32x16){}, (f32x16){}};
#pragma unroll
        for (int t = 0; t < 5; ++t)
#pragma unroll
            for (int s2 = 0; s2 < 2; ++s2) { const bf16x8 P = pack8(S[t], s2); const int k0 = 32 * (qg + t) + 16 * s2 + 4 * hh;
#pragma unroll
                for (int dt = 0; dt < 2; ++dt) O[dt] = MFMA32(trfrag(V, KSTR, k0, k0 + 8, 32 * dt, lane), P, O[dt]); }
#pragma unroll
        for (int dt = 0; dt < 2; ++dt)
#pragma unroll
            for (int gq = 0; gq < 4; ++gq) { const int c0 = head * 64 + 32 * dt + 8 * gq + 4 * hh; const u32x2 gt = *(const u32x2*)(PROJ + qrow * LDP + C_GA + c0);
                u32x2 w; w.x = cvtpk(O[dt][4 * gq] * inv * blo(gt.x), O[dt][4 * gq + 1] * inv * bhi(gt.x)); w.y = cvtpk(O[dt][4 * gq + 2] * inv * blo(gt.y), O[dt][4 * gq + 3] * inv * bhi(gt.y));
                *(u32x2*)(Y + qrow * DMIX + c0) = w; }
    }
    WG_SYNC();
}

constexpr int GMLP_ITEMS = 2 * 64 * 8, CONVWS_ITEMS = 32;
DI void convws_item(int it, const float* Ws  , bf16* WSB, int tid) {
    const int e0 = it * 4096 + tid * 8, i = (e0 >> 7) & 127, j0 = e0 & 127; const f32x4 a = *(const f32x4*)(Ws + e0), b = *(const f32x4*)(Ws + e0 + 4); v4u o;
    o.x = cvtpk(j0 <= i ? a[0] : 0.f, j0 + 1 <= i ? a[1] : 0.f); o.y = cvtpk(j0 + 2 <= i ? a[2] : 0.f, j0 + 3 <= i ? a[3] : 0.f);
    o.z = cvtpk(j0 + 4 <= i ? b[0] : 0.f, j0 + 5 <= i ? b[1] : 0.f); o.w = cvtpk(j0 + 6 <= i ? b[2] : 0.f, j0 + 7 <= i ? b[3] : 0.f);
    *(v4u*)(WSB + e0) = o;
}
DI void gmlp_item(int it, const bf16* PROJ, const bf16* WSB  , const float* bs  , const float* lng, const float* lnb, const float* VST, bf16* Y, ldsp lds, int tid, int wave, int lane) {
    const int hd = it & 7, tok0 = (it >> 3) * 128;
    ldsp WS = lds, VN = lds + 128 * VSTR; LAS float* ST = (LAS float*)(VN + 128 * KSTR);
    const int ct = wave & 1, itl = wave >> 1, hh = lane >> 5, r = lane & 31;
    v4u wsr[4], vr[2]; f32x4 st4[4]; u32x2 ur[4], gr[4];
#pragma unroll
    for (int ii = 0; ii < 4; ++ii) { const int idx = tid + 512 * ii; wsr[ii] = *(const v4u*)(WSB + (size_t)hd * 16384 + idx * 8); }
#pragma unroll
    for (int ii = 0; ii < 2; ++ii) { const int idx = tid + 512 * ii, t = idx >> 3, c8 = (idx & 7) * 8; vr[ii] = *(const v4u*)(PROJ + (size_t)(tok0 + t) * LDP + C_VB + hd * 64 + c8); }
    if (tid < 128) {
#pragma unroll
        for (int q = 0; q < 4; ++q) st4[q] = *(const f32x4*)(VST + (size_t)(tok0 + tid) * 16 + 4 * q); }
    const size_t row = (size_t)(tok0 + 32 * itl + r);
#pragma unroll
    for (int g = 0; g < 4; ++g) { const int c0 = hd * 64 + 32 * ct + 8 * g + 4 * hh; ur[g] = *(const u32x2*)(PROJ + row * LDP + C_UB + c0); gr[g] = *(const u32x2*)(PROJ + row * LDP + C_GB + c0); }
    const int c8a = (tid & 7) * 8; f32x4 lg0 = *(const f32x4*)(lng + hd * 64 + c8a), lg1 = *(const f32x4*)(lng + hd * 64 + c8a + 4), lb0 = *(const f32x4*)(lnb + hd * 64 + c8a), lb1 = *(const f32x4*)(lnb + hd * 64 + c8a + 4);
    const float bias = bs[hd * 128 + 32 * itl + r];
    if (tid < 128) { const float s1 = ((st4[0][0] + st4[0][2]) + (st4[1][0] + st4[1][2])) + ((st4[2][0] + st4[2][2]) + (st4[3][0] + st4[3][2])), s2 = ((st4[0][1] + st4[0][3]) + (st4[1][1] + st4[1][3])) + ((st4[2][1] + st4[2][3]) + (st4[3][1] + st4[3][3]));
        const float mu = s1 * (1.0f / 512.0f), var = fmaxf(s2 * (1.0f / 512.0f) - mu * mu, 0.f); ST[2 * tid] = mu; ST[2 * tid + 1] = 1.0f / sqrtf(var + EPS); }
#pragma unroll
    for (int ii = 0; ii < 4; ++ii) { const int idx = tid + 512 * ii, i = idx >> 4, c16 = idx & 15; *(LAS v4u*)(WS + i * VSTR + c16 * 16) = wsr[ii]; }
    WG_SYNC();
#pragma unroll
    for (int ii = 0; ii < 2; ++ii) { const int idx = tid + 512 * ii, t = idx >> 3; const float mu = ST[2 * t], rs = ST[2 * t + 1]; const v4u w = vr[ii]; v4u o;
        o.x = cvtpk((blo(w.x) - mu) * rs * lg0[0] + lb0[0], (bhi(w.x) - mu) * rs * lg0[1] + lb0[1]); o.y = cvtpk((blo(w.y) - mu) * rs * lg0[2] + lb0[2], (bhi(w.y) - mu) * rs * lg0[3] + lb0[3]);
        o.z = cvtpk((blo(w.z) - mu) * rs * lg1[0] + lb1[0], (bhi(w.z) - mu) * rs * lg1[1] + lb1[1]); o.w = cvtpk((blo(w.w) - mu) * rs * lg1[2] + lb1[2], (bhi(w.w) - mu) * rs * lg1[3] + lb1[3]);
        *(LAS v4u*)(VN + t * KSTR + c8a * 2) = o; }
    WG_SYNC();
    f32x16 acc = {};
    for (int ks = 0; ks < 2 * (itl + 1); ++ks) { const int k0 = 16 * ks + 8 * hh;
        acc = MFMA32(trfrag(VN, KSTR, k0, k0 + 4, 32 * ct, lane), lds16(WS + (32 * itl + r) * VSTR + k0 * 2), acc); }
#pragma unroll
    for (int g = 0; g < 4; ++g) { const int c0 = hd * 64 + 32 * ct + 8 * g + 4 * hh; const u32x2 u = ur[g], gt = gr[g];
        u32x2 w; w.x = cvtpk(blo(u.x) * (acc[4 * g] + bias) * blo(gt.x), bhi(u.x) * (acc[4 * g + 1] + bias) * bhi(gt.x));
        w.y = cvtpk(blo(u.y) * (acc[4 * g + 2] + bias) * blo(gt.y), bhi(u.y) * (acc[4 * g + 3] + bias) * bhi(gt.y));
        *(u32x2*)(Y + row * DMIX + 512 + c0) = w; }
    WG_SYNC();
}

constexpr int SSWA_ITEMS = 128;
DI void sswa_item(int bd, const bf16* PROJ, const float* stK, const float* stV, const float* rel_bias, const float* sink, float* outK, float* outV, bf16* Y, ldsp lds, int tid, int wave, int lane) {
    const size_t row = (size_t)(MP + bd);
    LAS float* Q = (LAS float*)lds;
    LAS float* KN = Q + 512;
    LAS float* VNW = KN + 128;
    LAS float* SC = VNW + 128;
    LAS float* RED = SC + 1024;
    const int p = tid & 31, kvh = p >> 4, d4 = (p & 15) * 4, rg = tid >> 5;
    const float* ksrc = stK + (size_t)bd * 16384; const float* vsrc = stV + (size_t)bd * 16384; float* kdst = outK + (size_t)bd * 16384; float* vdst = outV + (size_t)bd * 16384;
    f32x4 kr[8], vr[8];
#pragma unroll
    for (int i = 0; i < 8; ++i) { const int jj = rg + 16 * i, js = jj < 127 ? jj + 1 : 127; kr[i] = *(const f32x4*)(ksrc + js * 128 + p * 4); }
#pragma unroll
    for (int i = 0; i < 8; ++i) { const int jj = rg + 16 * i, js = jj < 127 ? jj + 1 : 127; vr[i] = *(const f32x4*)(vsrc + js * 128 + p * 4); }
    Q[tid] = b2f(PROJ[row * LDP + C_QA + tid]);
    if (tid < 128) KN[tid] = b2f(PROJ[row * LDP + C_KA + tid]); else if (tid < 256) VNW[tid - 128] = b2f(PROJ[row * LDP + C_VA + tid - 128]);
    float bia[8][4];
    if ((p & 15) == 0) {
#pragma unroll
        for (int i = 0; i < 8; ++i) { const int jj = rg + 16 * i;
#pragma unroll
            for (int g = 0; g < 4; ++g) bia[i][g] = rel_bias[T5_BUCKET[127 - jj] * 8 + kvh * 4 + g] * LOG2E; } }
    WG_SYNC();
#pragma unroll
    for (int i = 0; i < 8; ++i) { const int jj = rg + 16 * i; f32x4 kvec = kr[i];
        if (jj == 127) { kvec[0] = KN[p * 4]; kvec[1] = KN[p * 4 + 1]; kvec[2] = KN[p * 4 + 2]; kvec[3] = KN[p * 4 + 3]; }
        *(f32x4*)(kdst + jj * 128 + p * 4) = kvec;
        float sc[4];
#pragma unroll
        for (int g = 0; g < 4; ++g) { const LAS float* qp = Q + (kvh * 4 + g) * 64 + d4; sc[g] = (kvec[0] * qp[0] + kvec[1] * qp[1]) + (kvec[2] * qp[2] + kvec[3] * qp[3]); }
#pragma unroll
        for (int o = 1; o < 16; o <<= 1) {
#pragma unroll
            for (int g = 0; g < 4; ++g) sc[g] += __shfl_xor(sc[g], o); }
        if ((p & 15) == 0) {
#pragma unroll
            for (int g = 0; g < 4; ++g) SC[(kvh * 4 + g) * 128 + jj] = sc[g] + bia[i][g]; } }
    WG_SYNC();
    { const int head = wave; const float snk = sink[head] * LOG2E; const float s0 = SC[head * 128 + lane], s1 = SC[head * 128 + 64 + lane];
        float mx = fmaxf(fmaxf(s0, s1), snk);
#pragma unroll
        for (int o = 1; o < 64; o <<= 1) mx = fmaxf(mx, __shfl_xor(mx, o));
        const float p0 = __builtin_amdgcn_exp2f(s0 - mx), p1 = __builtin_amdgcn_exp2f(s1 - mx); float l = p0 + p1;
#pragma unroll
        for (int o = 1; o < 64; o <<= 1) l += __shfl_xor(l, o);
        l += __builtin_amdgcn_exp2f(snk - mx); const float inv = 1.0f / l;
        SC[head * 128 + lane] = p0 * inv; SC[head * 128 + 64 + lane] = p1 * inv; }
    const unsigned short gate = PROJ[row * LDP + C_GA + tid];
    WG_SYNC();
    float acc[4][4];
#pragma unroll
    for (int g = 0; g < 4; ++g)
#pragma unroll
        for (int c = 0; c < 4; ++c) acc[g][c] = 0.f;
#pragma unroll
    for (int i = 0; i < 8; ++i) { const int jj = rg + 16 * i; f32x4 vvec = vr[i];
        if (jj == 127) { vvec[0] = VNW[p * 4]; vvec[1] = VNW[p * 4 + 1]; vvec[2] = VNW[p * 4 + 2]; vvec[3] = VNW[p * 4 + 3]; }
        *(f32x4*)(vdst + jj * 128 + p * 4) = vvec;
#pragma unroll
        for (int g = 0; g < 4; ++g) { const float pr = SC[(kvh * 4 + g) * 128 + jj];
#pragma unroll
            for (int c = 0; c < 4; ++c) acc[g][c] += pr * vvec[c]; } }
#pragma unroll
    for (int g = 0; g < 4; ++g)
#pragma unroll
        for (int c = 0; c < 4; ++c) acc[g][c] += __shfl_xor(acc[g][c], 32);
    if (lane < 32) {
#pragma unroll
        for (int g = 0; g < 4; ++g)
#pragma unroll
            for (int c = 0; c < 4; ++c) RED[wave * 512 + (kvh * 4 + g) * 64 + d4 + c] = acc[g][c]; }
    WG_SYNC();
    { float o = 0.f;
#pragma unroll
        for (int q = 0; q < 8; ++q) o += RED[q * 512 + tid];
        Y[row * DMIX + tid] = f2b(o * b2f(gate)); }
    WG_SYNC();
}
constexpr int SGMLP_ITEMS = 16;
DI void sgmlp_item(int it, const bf16* PROJ, const float* Ws, const float* bs, const float* lng, const float* lnb, float* cv  , bf16* Y, int wave, int lane) {
    const int bd = it * 8 + wave; const size_t row = (size_t)(MP + bd); const int c0 = lane * 8, hd = lane >> 3;
    const v4u w = *(const v4u*)(PROJ + row * LDP + C_VB + c0); float v[8]; float s1 = 0.f, s2 = 0.f;
#pragma unroll
    for (int e = 0; e < 4; ++e) { v[2 * e] = blo(w[e]); v[2 * e + 1] = bhi(w[e]); }
#pragma unroll
    for (int e = 0; e < 8; ++e) s1 += v[e];
#pragma unroll
    for (int o = 1; o < 64; o <<= 1) s1 += __shfl_xor(s1, o);
    const float mu = s1 * (1.0f / 512.0f);
#pragma unroll
    for (int e = 0; e < 8; ++e) { v[e] -= mu; s2 += v[e] * v[e]; }
#pragma unroll
    for (int o = 1; o < 64; o <<= 1) s2 += __shfl_xor(s2, o);
    const float rs = 1.0f / sqrtf(s2 * (1.0f / 512.0f) + EPS), w00 = Ws[(size_t)hd * 16384], b0 = bs[hd * 128];
    const v4u uu = *(const v4u*)(PROJ + row * LDP + C_UB + c0), gg = *(const v4u*)(PROJ + row * LDP + C_GB + c0); float vn[8]; v4u o;
#pragma unroll
    for (int e = 0; e < 8; ++e) vn[e] = v[e] * rs * lng[c0 + e] + lnb[c0 + e];
    *(f32x4*)(cv + (size_t)bd * 512 + c0) = (f32x4){vn[0], vn[1], vn[2], vn[3]}; *(f32x4*)(cv + (size_t)bd * 512 + c0 + 4) = (f32x4){vn[4], vn[5], vn[6], vn[7]};
#pragma unroll
    for (int e = 0; e < 4; ++e) o[e] = cvtpk(blo(uu[e]) * (w00 * vn[2 * e] + b0) * blo(gg[e]), bhi(uu[e]) * (w00 * vn[2 * e + 1] + b0) * bhi(gg[e]));
    *(v4u*)(Y + row * DMIX + 512 + c0) = o;
}
constexpr int SGLA_ITEMS = 128;
DI void sgla_item(int bd, const bf16* PROJ, const float* LA, const float* st0  , const float* gn, float* sout  , bf16* Y, ldsp lds, int tid, int wave, int lane) {
    const size_t row = (size_t)(MP + bd);
    LAS float* QS = (LAS float*)lds; LAS float* KS = QS + 256; LAS float* AS = KS + 256; LAS float* RED = AS + 256; LAS float* SS = RED + 4 * 8 * 128;
    const int dv4 = (tid & 31) * 4, dg = tid >> 5;
    const float* s0 = st0 + (size_t)bd * 32768; float* so = sout + (size_t)bd * 32768;
    f32x4 st[4][4];
#pragma unroll
    for (int h = 0; h < 4; ++h)
#pragma unroll
        for (int i = 0; i < 4; ++i) st[h][i] = *(const f32x4*)(s0 + h * 8192 + (dg + 16 * i) * 128 + dv4);
    u32x2 vw[4];
#pragma unroll
    for (int h = 0; h < 4; ++h) vw[h] = *(const u32x2*)(PROJ + row * LDP + C_VC + h * 128 + dv4);
    if (tid < 256) { QS[tid] = b2f(PROJ[row * LDP + C_QC + tid]); KS[tid] = b2f(PROJ[row * LDP + C_KC + tid]); AS[tid] = __expf(LA[row * 256 + tid]); }
    const float gnv = gn[tid]; const unsigned short gate = PROJ[row * LDP + C_GC + tid];
    WG_SYNC();
#pragma unroll
    for (int h = 0; h < 4; ++h) { const f32x4 vv = {blo(vw[h].x), bhi(vw[h].x), blo(vw[h].y), bhi(vw[h].y)}; f32x4 op = {0.f, 0.f, 0.f, 0.f};
#pragma unroll
        for (int i = 0; i < 4; ++i) { const int d = h * 64 + dg + 16 * i; const f32x4 sf = st[h][i] * AS[d] + vv * KS[d];
            *(f32x4*)(so + h * 8192 + (dg + 16 * i) * 128 + dv4) = sf; op += sf * QS[d]; }
#pragma unroll
        for (int c = 0; c < 4; ++c) op[c] += __shfl_xor(op[c], 32);
        if (lane < 32) *(LAS f32x4*)(RED + (h * 8 + wave) * 128 + dv4) = op; }
    WG_SYNC();
    const int h2 = tid >> 7, dv = tid & 127; float o = 0.f;
#pragma unroll
    for (int q = 0; q < 8; ++q) o += RED[(h2 * 8 + q) * 128 + dv];
    float ss = o * o;
#pragma unroll
    for (int x = 1; x < 64; x <<= 1) ss += __shfl_xor(ss, x);
    if (lane == 0) SS[wave] = ss;
    WG_SYNC();
    const float rs = 1.0f / sqrtf((SS[2 * h2] + SS[2 * h2 + 1]) * (1.0f / 128.0f) + EPS);
    Y[row * DMIX + 1024 + tid] = f2b(o * rs * gnv * b2f(gate));
    WG_SYNC();
}
constexpr int NWAVES = 8;
constexpr int NPH = 23;
constexpr int N_LAUNCHES = MK_N_LAUNCHES;
static_assert(N_LAUNCHES == 1 || N_LAUNCHES == NPH, "MK_N_LAUNCHES is 1 or 23");
constexpr size_t MiB = 1u << 20;
constexpr size_t WS_CTL = 0, CTL_ZERO_BYTES = 65536;
constexpr size_t WS_WIN = 1 * MiB;
constexpr size_t WS_WOUT = 10 * MiB;
constexpr size_t WS_XB = 13 * MiB;
constexpr size_t WS_PROJ = 46 * MiB;
constexpr size_t WS_LA = 184 * MiB;
constexpr size_t WS_Y = 201 * MiB;
constexpr size_t WS_DS = 250 * MiB;
constexpr size_t WS_AG = 65536;
constexpr size_t WS_ROWSS = 327680;
constexpr size_t WS_WSB = 786432;
constexpr size_t WS_VST = 282 * MiB;
constexpr size_t WS_WOUT2 = 283 * MiB + MiB / 4;
constexpr size_t WS_END = 286 * MiB + MiB / 4;
static_assert(WS_XB + (size_t)MT * DM * 2 <= WS_PROJ && WS_PROJ + (size_t)MT * LDP * 2 <= WS_LA && WS_LA + (size_t)MT * 256 * 4 <= WS_Y && WS_Y + (size_t)MT * DMIX * 2 <= WS_DS && WS_AG + (size_t)1024 * 64 * 4 <= WS_ROWSS && WS_ROWSS + (size_t)4 * MT * 4 <= WS_WSB && WS_WSB + 262144 <= WS_WIN && WS_DS + (size_t)1024 * 8192 * 4 <= WS_VST && WS_VST + (size_t)MT * 64 <= WS_WOUT2 && WS_WOUT2 + 3 * MiB <= WS_END, "d_ws map");
constexpr int CW_BAR = 4096;
static_assert(WSO_XB == WS_XB && WSO_PROJ == WS_PROJ && WSO_LA == WS_LA && WSO_ROWSS == WS_ROWSS && WSO_VST == WS_VST, "header copies of the d_ws map");
static_assert((CW_BAR + XCD_BAR_WORDS) * 4 <= (int)CTL_ZERO_BYTES, "barrier words inside the memset region");
static_assert(true, "");
constexpr size_t O_YP = 0, O_YS = 16777216, O_KP = 16908288, O_VP = 17039360, O_GP = 17170432, O_KS = 17432576, O_VS = 25821184, O_GS = 34209792, O_CV = 50987008, O_END = 51249152;
constexpr int RING_BYTES = 131072, LDSCTL_OFF = RING_BYTES, MISC_OFF = LDSCTL_OFF + 320, RS_OFF = 132096  , SM_OFF = 140288  , LDS_BYTES = 163840;


#ifndef SMHOOK
#define SMHOOK 1
#endif
struct HookOrder : pg8::StaticOrder {
    mutable int k; int l, j, tid; ldsp lds2;
    __device__ __forceinline__ void done(const pg8::Unit&) const {
        const int kk = k; k = kk + 1;
        if (j < 0) return;
        int tid = this->tid; asm volatile("" : "+v"(tid));
        const int lane = tid & 63, wave = __builtin_amdgcn_readfirstlane(tid >> 6);
        const kargs_t ka = KA(); const bf16* proj = (const bf16*)(ka->ws + WS_PROJ); bf16* y = (bf16*)(ka->ws + WS_Y); float* o = ka->out;
        if (kk == 0) sswa_item(j, proj, ka->in[2] + (size_t)l * 2097152, ka->in[3] + (size_t)l * 2097152, ka->in[5], ka->in[8] + l * 8, o + O_KS + (size_t)l * 2097152, o + O_VS + (size_t)l * 2097152, y, lds2, tid, wave, lane);
        else if (kk == 1) sgla_item(j, proj, (const float*)(ka->ws + WS_LA), ka->in[4] + (size_t)l * 4194304, ka->in[15] + l * 512, o + O_GS + (size_t)l * 4194304, y, lds2, tid, wave, lane);
        else if (kk == 2 && j < SGMLP_ITEMS) sgmlp_item(j, proj, ka->in[9] + (size_t)l * 131072, ka->in[10] + l * 1024, ka->in[11] + l * 512, ka->in[12] + l * 512, o + O_CV + (size_t)l * 65536, y, wave, lane);
    }
};

__global__ void __launch_bounds__(NWAVES * 64, 2) hymba_fwd(Args args) {
    extern __shared__ __attribute__((aligned(16))) unsigned char lds_raw[];
    ldsp lds = (ldsp)lds_raw;
    volatile LAS unsigned* MISC = (volatile LAS unsigned*)(lds + MISC_OFF);
    const int tid0 = threadIdx.x;
    const int G0 = gridDim.x, bx0 = blockIdx.x, vcu0 = (G0 % 8 == 0) ? (bx0 % 8) * (G0 / 8) + bx0 / 8 : bx0;
#define PHASE_LOCALS int tid = tid0, G = G0, bx = bx0, vcu = vcu0; asm volatile("" : "+v"(tid), "+s"(G), "+s"(bx), "+s"(vcu)); const int lane = tid & 63, wave = __builtin_amdgcn_readfirstlane(tid >> 6); (void)lane; (void)wave; (void)bx; (void)vcu; (void)G;
    gu32* ctl = (gu32*)(KA()->ws + WS_CTL);
#define x_prompt (KA()->in[0])
#define x_sample (KA()->in[1])
#define st_k (KA()->in[2])
#define st_v (KA()->in[3])
#define st_g (KA()->in[4])
#define rel_bias (KA()->in[5])
#define norm_g (KA()->in[6])
#define w_in (KA()->in[7])
#define sinks (KA()->in[8])
#define sp_w (KA()->in[9])
#define sp_b (KA()->in[10])
#define ln_g (KA()->in[11])
#define ln_b (KA()->in[12])
#define w_up (KA()->in[13])
#define b_up (KA()->in[14])
#define gla_gn (KA()->in[15])
#define w_out (KA()->in[16])
#define fin_g (KA()->in[17])
#define out (KA()->out)
#define WIN ((bf16*)(KA()->ws + WS_WIN))
#define WOUTL(ll) ((bf16*)(KA()->ws + (((ll) & 1) ? WS_WOUT2 : WS_WOUT)))
#define XB ((bf16*)(KA()->ws + WS_XB))
#define PROJ ((bf16*)(KA()->ws + WS_PROJ))
#define LAB ((float*)(KA()->ws + WS_LA))
#define Y ((bf16*)(KA()->ws + WS_Y))
#define DS ((float*)(KA()->ws + WS_DS))
#define AG ((float*)(KA()->ws + WS_AG))
#define ROWSS ((float*)(KA()->ws + WS_ROWSS))
#define WSB ((bf16*)(KA()->ws + WS_WSB))
#define VST ((float*)(KA()->ws + WS_VST))
    for (int u = tid0; u < (LDS_BYTES - LDSCTL_OFF) / 4; u += NWAVES * 64) ((LAS unsigned*)(lds + LDSCTL_OFF))[u] = 0u;
    __syncthreads();
    XcdBarrier bar; bar.bar = (unsigned*)(ctl + CW_BAR); bar.x = 0; bar.st = nullptr;
    if (N_LAUNCHES == 1) bar = xcd_barrier_post((unsigned*)(ctl + CW_BAR), MISC + 8);
    const int lo = KA()->ph_lo, hi = KA()->ph_hi;
#ifndef DISMASK
#define DISMASK 0
#endif
#define IN(k) (lo <= (k) && (k) < hi)
#define EN(b) (!((DISMASK >> (b)) & 1))
#ifndef REPMASK
#define REPMASK 0
#endif
#define REPS(b) (((REPMASK >> (b)) & 1) ? 2 : 1)
#define SEAM(k) do { if (IN(k) && IN((k) + 1)) { xcd_barrier(bar); if (REPMASK & 16) xcd_barrier(bar); } } while (0)

    if (IN(0) && EN(0)) for (int rep_ = 0; rep_ < REPS(5); ++rep_) { PHASE_LOCALS
        int it = vcu;
        for (; it < CONV_IN_ITEMS; it += G) conv_in_item(it, w_in, w_up, norm_g, WIN, lds, wave, lane);
        it -= CONV_IN_ITEMS;
        for (; it < CONV_OUT_ITEMS; it += G) conv_out_item(it, w_out, WOUTL(0), lds, wave, lane);
        it -= CONV_OUT_ITEMS;
        for (; it < MT / 8; it += G) { const int row = it * 8 + wave;
            if (row < MP) row_to_bf16(x_prompt + (size_t)row * DM, XB + (size_t)row * DM, ROWSS + row, ROWSS + MT + row, ROWSS + 2 * MT + row, ROWSS + 3 * MT + row, lane);
            else row_to_bf16(x_sample + (size_t)(row - MP) * DM, XB + (size_t)row * DM, nullptr, nullptr, nullptr, nullptr, lane); }
        __syncthreads();
    }
    SEAM(0);
    if (IN(1) && EN(0)) { PHASE_LOCALS
        for (int it = vcu; it < SIN_ITEMS; it += G) sin_item(it, XB, WIN, PROJ, LAB, b_up, wave, lane);
    }
    SEAM(1);

    for (int l = 0; l < DEPTH; ++l) {
        const int pb = 2 + 5 * l;
        if (IN(pb) && EN(1)) for (int rep_ = 0; rep_ < REPS(0); ++rep_) { PHASE_LOCALS
            const int pm0 = 8 * (bx & 7);
            { LAS float* RS = (LAS float*)(lds + RS_OFF); const float* rss = ROWSS;
#pragma unroll
              for (int i = 0; i < 4; ++i) { const int rl = tid + 512 * i, r = pm0 * 256 + rl; RS[rl] = 1.0f / sqrtf(((rss[r] + rss[MT + r]) + (rss[2 * MT + r] + rss[3 * MT + r])) * (1.0f / DM) + EPS); }
              __syncthreads(); }
            pg8::Gemm g{XB, WIN, MP, NIN, DM}; HookOrder S; S.init(MP, NIN, G, bx);
            { const int nwg = (MP / 256) * (NIN / 256), base = nwg % G; S.k = 0; S.l = l; S.j = (SMHOOK && base != 0 && bx >= base && G - base == SSWA_ITEMS) ? bx - base : -1; S.tid = tid; S.lds2 = lds + SM_OFF; }
            pg8::EpiIn E{l, pm0, (const LAS float*)(lds + RS_OFF)};
            pg8::gemm_phase<pg8::EpiIn, HookOrder, true, true>(lds, g, S, E);
            __syncthreads();
        }
        SEAM(pb);
        if (IN(pb + 1) && EN(2)) for (int rep_ = 0; rep_ < REPS(1); ++rep_) { PHASE_LOCALS
            int it = vcu;
            for (; it < GLA_ITEMS; it += G) gla1_item(it, PROJ, LAB, DS, AG, lds, tid, wave, lane);
            it -= GLA_ITEMS;
            if (SMHOOK) { for (; it < SOUT_ITEMS; it += G) sout_item(it, Y, WOUTL(l), out + O_YS, XB, l == DEPTH - 1, wave, lane);
            it -= SOUT_ITEMS; }
            else {
            for (; it < SSWA_ITEMS; it += G) sswa_item(it, PROJ, st_k + (size_t)l * 2097152, st_v + (size_t)l * 2097152, rel_bias, sinks + l * 8, out + O_KS + (size_t)l * 2097152, out + O_VS + (size_t)l * 2097152, Y, lds, tid, wave, lane);
            it -= SSWA_ITEMS;
            for (; it < SGLA_ITEMS; it += G) sgla_item(it, PROJ, LAB, st_g + (size_t)l * 4194304, gla_gn + l * 512, out + O_GS + (size_t)l * 4194304, Y, lds, tid, wave, lane);
            it -= SGLA_ITEMS;
            for (; it < SGMLP_ITEMS; it += G) sgmlp_item(it, PROJ, sp_w + (size_t)l * 131072, sp_b + l * 1024, ln_g + l * 512, ln_b + l * 512, out + O_CV + (size_t)l * 65536, Y, wave, lane);
            it -= SGMLP_ITEMS; }
            for (; it < CONVWS_ITEMS; it += G) convws_item(it, sp_w + (size_t)l * 131072, WSB, tid);
            it -= CONVWS_ITEMS;
            if (l + 1 < DEPTH) for (; it < CONV_IN_ITEMS; it += G) conv_in_item(it, w_in + (size_t)(l + 1) * DM * DIN_RAW, w_up + (l + 1) * 4096, norm_g + (l + 1) * DM, WIN, lds, wave, lane);
            __syncthreads();
        }
        SEAM(pb + 1);
        if (IN(pb + 2) && EN(3)) { PHASE_LOCALS
            int it = vcu;
            if (REPMASK & 256) { for (int it2 = it; it2 < SCAN_ITEMS; it2 += G) scan_item(it2, DS, (float*)XB, AG, out + O_GP + (size_t)l * 65536, lds, tid); }
            for (; it < SCAN_ITEMS; it += G) scan_item(it, DS, DS, AG, out + O_GP + (size_t)l * 65536, lds, tid);
            it -= SCAN_ITEMS;
            { const int it_c = it; for (int rep_ = 0; rep_ < REPS(2); ++rep_) { it = it_c;
            for (; it < SWA_ITEMS; it += G) swa_item(it, PROJ, rel_bias, sinks + l * 8, Y, lds, tid, wave, lane); } }
            it -= SWA_ITEMS;
            { const int it_c = it; for (int rep_ = 0; rep_ < REPS(6); ++rep_) { it = it_c;
            for (; it < GMLP_ITEMS; it += G) gmlp_item(it, PROJ, WSB, sp_b + l * 1024, ln_g + l * 512, ln_b + l * 512, VST, Y, lds, tid, wave, lane); } }
            it -= GMLP_ITEMS;
            if (SMHOOK) { if (l + 1 < DEPTH) for (; it < SIN_ITEMS; it += G) sin_item(it, XB, WIN, PROJ, LAB, b_up + (l + 1) * 256, wave, lane); }
            else { for (; it < SOUT_ITEMS; it += G) sout_item(it, Y, WOUTL(l), out + O_YS, XB, l == DEPTH - 1, wave, lane); }
            __syncthreads();
        }
        SEAM(pb + 2);
        if (IN(pb + 3) && EN(4)) for (int rep_ = 0; rep_ < REPS(3); ++rep_) { PHASE_LOCALS
            int it = vcu;
            for (; it < GLA_ITEMS; it += G) gla2_item(it, PROJ, LAB, DS, gla_gn + l * 512, Y, lds, tid, wave, lane);
            it -= GLA_ITEMS;
            if (l + 1 < DEPTH) for (; it < CONV_OUT_ITEMS; it += G) conv_out_item(it, w_out + (size_t)(l + 1) * DMIX * DM, WOUTL(l + 1), lds, wave, lane);
            it -= CONV_OUT_ITEMS;
            if (!SMHOOK && l + 1 < DEPTH) { __syncthreads(); for (; it < SIN_ITEMS; it += G) sin_item(it, XB, WIN, PROJ, LAB, b_up + (l + 1) * 256, wave, lane); }
            __syncthreads();
        }
        SEAM(pb + 3);
        if (IN(pb + 4) && EN(5)) { PHASE_LOCALS
            pg8::Gemm g{Y, WOUTL(l), MP, DM, DMIX}; pg8::StaticOrder S; S.init(MP, DM, G, bx);
            pg8::EpiOut E{l};
            pg8::gemm_phase<pg8::EpiOut, pg8::StaticOrder, false, true>(lds, g, S, E);
            __syncthreads();
        }
        SEAM(pb + 4);
    }
    if (IN(NPH - 1) && EN(6)) { PHASE_LOCALS
        for (int it = vcu; it < MT / 8; it += G) final_row(out + O_YP + (size_t)(it * 8 + wave) * DM, fin_g, lane);
    }
#undef IN
#undef SEAM
#undef out
}

extern "C" void kernel_launch(void* const* d_in, const int* in_sizes, int n_in, void* d_out, int out_size, void* d_ws, size_t ws_size, hipStream_t stream) {
    static int grid = 0;
    if (grid == 0) {
        if (n_in != 18 || in_sizes[0] != MP * DM || (size_t)out_size != O_END || ws_size < WS_END) {
            fprintf(stderr, "kernel_launch: shape mismatch: n_in %d in0 %d out %d ws %zu (need >= %zu)\n", n_in, n_in > 0 ? in_sizes[0] : -1, out_size, ws_size, (size_t)WS_END); grid = -1; return; }
        int dev = 0, cus = 0, per_cu = 0;
        if (hipGetDevice(&dev) != hipSuccess || hipDeviceGetAttribute(&cus, hipDeviceAttributeMultiprocessorCount, dev) != hipSuccess) { fprintf(stderr, "kernel_launch: device query failed\n"); grid = -1; return; }
        if (hipFuncSetAttribute((const void*)hymba_fwd, hipFuncAttributeMaxDynamicSharedMemorySize, LDS_BYTES) != hipSuccess) { fprintf(stderr, "kernel_launch: hipFuncSetAttribute failed\n"); grid = -1; return; }
        if (hipOccupancyMaxActiveBlocksPerMultiprocessor(&per_cu, (const void*)hymba_fwd, NWAVES * 64, LDS_BYTES) != hipSuccess || per_cu < 1) { fprintf(stderr, "kernel_launch: occupancy query says %d blocks per CU\n", per_cu); (void)hipGetLastError(); grid = -1; return; }
        (void)hipGetLastError();
        grid = cus;
        if (grid != 256) { fprintf(stderr, "kernel_launch: built for 256 CUs, device has %d\n", cus); grid = -1; return; }
    }
    if (grid < 0) return;
    if (hipMemsetAsync((char*)d_ws + WS_CTL, 0, CTL_ZERO_BYTES, stream) != hipSuccess) { fprintf(stderr, "kernel_launch: memset failed\n"); return; }
    Args a{};
    for (int i = 0; i < 18; ++i) a.in[i] = (const float*)d_in[i];
    a.out = (float*)d_out; a.ws = (unsigned char*)d_ws;
    for (int li = 0; li < N_LAUNCHES; ++li) {
        a.ph_lo = (N_LAUNCHES == 1) ? 0 : li; a.ph_hi = (N_LAUNCHES == 1) ? NPH : li + 1; a.li = li; a.pad = 0;
        hipLaunchKernelGGL(hymba_fwd, dim3(grid), dim3(NWAVES * 64), LDS_BYTES, stream, a);
        const hipError_t le = hipPeekAtLastError();
        if (le != hipSuccess) { fprintf(stderr, "kernel_launch: launch %d failed: %s\n", li, hipGetErrorName(le)); break; }
    }
}
```
